# Optimizing an MI355X kernel written in HIP

```python
import jax, jax.numpy as jnp
from jax import lax
import numpy as np

D_MODEL = 2048
BATCH = 4
SEQ = 8192
DEPTH = 1

D_MIX = D_MODEL
GM_WIDTH = D_MIX // 2
LRU_WIDTH = D_MIX - GM_WIDTH
CHUNK = 128
GM_HEADS = 8
GM_HEAD_DIM = GM_WIDTH // GM_HEADS
LRU_HEADS = 8
LRU_BLOCK = LRU_WIDTH // LRU_HEADS
LRU_CONV = 4
LRU_C = 8.0
FFN_MULT = 3
D_FF = FFN_MULT * D_MODEL
FFN_CONV = 3
IN_COLS = 2 * GM_WIDTH + 2 * LRU_WIDTH
RMS_EPS = 1e-6
LN_EPS = 1e-5

kernel_name = "hymba_style_gmlp_rglru_convffn"


def _rmsnorm(x, g):
    xf = x.astype(jnp.float32)
    y = xf * lax.rsqrt(jnp.mean(xf * xf, axis=-1, keepdims=True) + RMS_EPS)
    return (y * g.astype(jnp.float32)).astype(x.dtype)


def _layernorm(x, g, b):
    xf = x.astype(jnp.float32)
    mu = jnp.mean(xf, axis=-1, keepdims=True)
    xc = xf - mu
    y = xc * lax.rsqrt(jnp.mean(xc * xc, axis=-1, keepdims=True) + LN_EPS)
    return (y * g.astype(jnp.float32) + b.astype(jnp.float32)).astype(x.dtype)


def _causal_dwconv(x, w, b):
    k_width = w.shape[0]
    s = x.shape[1]
    xp = jnp.pad(x, ((0, 0), (k_width - 1, 0), (0, 0)))
    y = b
    for k in range(k_width):
        y = y + xp[:, k:k + s] * w[k]
    return y


def _spatial_gating(z, v_g, v_b, ws, bs):
    u, v = jnp.split(z, 2, axis=-1)
    v = _layernorm(v, v_g, v_b)
    bsz, s, _ = v.shape
    vc = v.reshape(bsz, s // CHUNK, CHUNK, GM_HEADS, GM_HEAD_DIM)
    mask = jnp.tril(jnp.ones((CHUNK, CHUNK), dtype=bool))
    w = jnp.where(mask[None], ws, jnp.zeros((), ws.dtype))
    mixed = jnp.einsum('hts,bcshd->bcthd', w, vc) + bs.T[None, None, :, :, None]
    return u * mixed.reshape(bsz, s, GM_WIDTH)


def _lru_combine(left, right):
    a1, b1 = left
    a2, b2 = right
    return a1 * a2, a2 * b1 + b2


def _rg_lru(x, wa, ba, wx, bx, lam):
    bsz, s, w = x.shape
    xh = x.reshape(bsz, s, LRU_HEADS, LRU_BLOCK)
    r = jax.nn.sigmoid(jnp.einsum('bshi,hij->bshj', xh, wa) + ba).reshape(bsz, s, w)
    i = jax.nn.sigmoid(jnp.einsum('bshi,hij->bshj', xh, wx) + bx).reshape(bsz, s, w)
    log_a = -LRU_C * r.astype(jnp.float32) * jax.nn.softplus(-lam.astype(jnp.float32))
    a = jnp.exp(log_a)
    mult = jnp.sqrt(-jnp.expm1(2.0 * log_a))
    b = mult * (i * x).astype(jnp.float32)
    _, h = lax.associative_scan(_lru_combine, (a, b), axis=1)
    return h.astype(x.dtype)


def setup_inputs(seed: int = 0) -> dict:
    key = jax.random.key(seed)
    ks = jax.random.split(key, 24)
    f32 = jnp.float32
    L = DEPTH

    def nrm(k, shape, scale):
        return jax.random.normal(k, shape, f32) * scale

    x = jax.random.normal(ks[0], (BATCH, SEQ, D_MODEL), f32)
    norm1_g = 1.0 + nrm(ks[1], (L, D_MODEL), 0.05)
    w_in = nrm(ks[2], (L, D_MODEL, IN_COLS), D_MODEL ** -0.5)
    gm_v_g = 1.0 + nrm(ks[3], (L, GM_WIDTH), 0.05)
    gm_v_b = nrm(ks[4], (L, GM_WIDTH), 0.02)
    gm_ws = nrm(ks[5], (L, GM_HEADS, CHUNK, CHUNK), CHUNK ** -0.5)
    gm_bs = 1.0 + nrm(ks[6], (L, GM_HEADS, CHUNK), 0.1)
    lru_conv_w = nrm(ks[7], (L, LRU_CONV, LRU_WIDTH), LRU_CONV ** -0.5)
    lru_conv_b = nrm(ks[8], (L, LRU_WIDTH), 0.02)
    lru_wa = nrm(ks[9], (L, LRU_HEADS, LRU_BLOCK, LRU_BLOCK), LRU_BLOCK ** -0.5)
    lru_ba = nrm(ks[10], (L, LRU_HEADS, LRU_BLOCK), 0.02)
    lru_wx = nrm(ks[11], (L, LRU_HEADS, LRU_BLOCK, LRU_BLOCK), LRU_BLOCK ** -0.5)
    lru_bx = nrm(ks[12], (L, LRU_HEADS, LRU_BLOCK), 0.02)
    a_c = jax.random.uniform(ks[13], (L, LRU_WIDTH), f32, 0.9, 0.999)
    a_base = a_c ** (1.0 / LRU_C)
    lru_lambda = jnp.log(a_base) - jnp.log1p(-a_base)
    gm_out_g = 1.0 + nrm(ks[14], (L, GM_WIDTH), 0.05)
    lru_out_g = 1.0 + nrm(ks[15], (L, LRU_WIDTH), 0.05)
    w_out = nrm(ks[16], (L, D_MIX, D_MODEL), D_MIX ** -0.5)
    norm2_g = 1.0 + nrm(ks[17], (L, D_MODEL), 0.05)
    ffn_w_up = nrm(ks[18], (L, D_MODEL, 2 * D_FF), D_MODEL ** -0.5)
    ffn_conv_w = nrm(ks[19], (L, FFN_CONV, 2 * D_FF), FFN_CONV ** -0.5)
    ffn_conv_b = nrm(ks[20], (L, 2 * D_FF), 0.02)
    ffn_w_down = nrm(ks[21], (L, D_FF, D_MODEL), D_FF ** -0.5)
    final_g = 1.0 + nrm(ks[22], (D_MODEL,), 0.05)
    return {
        "x": x, "norm1_g": norm1_g, "w_in": w_in,
        "gm_v_g": gm_v_g, "gm_v_b": gm_v_b, "gm_ws": gm_ws, "gm_bs": gm_bs,
        "lru_conv_w": lru_conv_w, "lru_conv_b": lru_conv_b,
        "lru_wa": lru_wa, "lru_ba": lru_ba, "lru_wx": lru_wx, "lru_bx": lru_bx,
        "lru_lambda": lru_lambda, "gm_out_g": gm_out_g, "lru_out_g": lru_out_g,
        "w_out": w_out, "norm2_g": norm2_g, "ffn_w_up": ffn_w_up,
        "ffn_conv_w": ffn_conv_w, "ffn_conv_b": ffn_conv_b, "ffn_w_down": ffn_w_down,
        "final_g": final_g,
    }


def reference(x, norm1_g, w_in, gm_v_g, gm_v_b, gm_ws, gm_bs, lru_conv_w, lru_conv_b,
              lru_wa, lru_ba, lru_wx, lru_bx, lru_lambda, gm_out_g, lru_out_g, w_out,
              norm2_g, ffn_w_up, ffn_conv_w, ffn_conv_b, ffn_w_down, final_g):
    for l in range(DEPTH):
        h = _rmsnorm(x, norm1_g[l])
        p = jnp.einsum('bsd,de->bse', h, w_in[l])
        z_gm = p[..., :2 * GM_WIDTH]
        g_lru = p[..., 2 * GM_WIDTH:2 * GM_WIDTH + LRU_WIDTH]
        x_lru = p[..., 2 * GM_WIDTH + LRU_WIDTH:]
        y_gm = _spatial_gating(jax.nn.gelu(z_gm), gm_v_g[l], gm_v_b[l], gm_ws[l], gm_bs[l])
        xr = _causal_dwconv(x_lru, lru_conv_w[l], lru_conv_b[l])
        y_lru = _rg_lru(xr, lru_wa[l], lru_ba[l], lru_wx[l], lru_bx[l], lru_lambda[l])
        y_lru = y_lru * jax.nn.gelu(g_lru)
        y = jnp.concatenate([_rmsnorm(y_gm, gm_out_g[l]), _rmsnorm(y_lru, lru_out_g[l])], axis=-1)
        x = x + jnp.einsum('bse,ed->bsd', y, w_out[l])
        h = _rmsnorm(x, norm2_g[l])
        up = jnp.einsum('bsd,df->bsf', h, ffn_w_up[l])
        up = _causal_dwconv(up, ffn_conv_w[l], ffn_conv_b[l])
        gate, val = jnp.split(up, 2, axis=-1)
        x = x + jnp.einsum('bsf,fd->bsd', jax.nn.gelu(gate) * val, ffn_w_down[l])
    return _rmsnorm(x, final_g)
```

```cpp
#include <hip/hip_runtime.h>
#include <hip/hip_cooperative_groups.h>
#include <cstdio>
#include <cstdint>
namespace cg = cooperative_groups;
namespace pg8 {
#define PG8_LAS __attribute__((address_space(3)))
typedef unsigned short bf16_t;
typedef short bf16x8 __attribute__((ext_vector_type(8)));
typedef float f32x4 __attribute__((ext_vector_type(4)));
typedef unsigned u32x4 __attribute__((ext_vector_type(4)));
constexpr int BM = 256, BK = 64, HALF = 128, HTB = HALF * BK * 2  , STAGE_BYTES = 8 * HTB, NXCD = 8, WGM = 4;

__host__ __device__ __forceinline__ int lds_byte(int r, int c) { const int st = (r >> 4) * 2 + (c >> 5), rr = r & 15, cc = c & 31, ob = rr * 64 + cc * 2; return st * 1024 + (ob ^ (((ob >> 9) & 1) << 5)); }
__host__ __device__ __forceinline__ void stage_rc(int b, int& R, int& C) { const int st = b / 1024, sb = b % 1024, swz = sb ^ (((sb >> 9) & 1) << 5); R = (st >> 1) * 16 + swz / 64; C = (st & 1) * 32 + (swz % 64) / 2; }
__host__ __device__ __forceinline__ int perm32(int rho) { const int n = rho >> 4, i = rho & 15; return 8 * (i >> 2) + 4 * n + (i & 3); }

struct Unit { int pm, pn; };
struct Gemm { const bf16_t* A; const bf16_t* Bt; int M, N, K; };

struct StaticOrder {
    int nM, nN, nwg, G, c;
    __host__ __device__ void init(int M, int N, int G_, int c_) { nM = M / BM; nN = N / BM; nwg = nM * nN; G = G_; c = c_; }
    __host__ __device__ bool next(int i, Unit& u) const {
        const long L = (long)i * G + c; if (L >= nwg) return false;
        int wgid = (int)L; { const int q = nwg / NXCD, r = nwg % NXCD, xcd = wgid % NXCD, off = wgid / NXCD; wgid = (xcd < r ? xcd * (q + 1) : r * (q + 1) + (xcd - r) * q) + off; }
        const int nig = WGM * nN, gid = wgid / nig, fm = gid * WGM, gsz = (nM - fm) < WGM ? (nM - fm) : WGM;
        u.pm = fm + ((wgid % nig) % gsz); u.pn = (wgid % nig) / gsz; return true;
    }
    __device__ __forceinline__ void a_ready(const Unit&) const {}
    __device__ __forceinline__ void done(const Unit&) const {}
};

typedef unsigned u32x2 __attribute__((ext_vector_type(2)));
typedef float f32x2 __attribute__((ext_vector_type(2)));
__device__ __forceinline__ unsigned cvt_pk_bf16(float lo, float hi) { unsigned r; asm volatile("v_cvt_pk_bf16_f32 %0, %1, %2" : "=v"(r) : "v"(lo), "v"(hi)); return r; }
__device__ __forceinline__ float bf_lo(unsigned w) { return __builtin_bit_cast(float, w << 16); }
__device__ __forceinline__ float bf_hi(unsigned w) { return __builtin_bit_cast(float, w & 0xffff0000u); }
__device__ __forceinline__ float gelu_tanh(float x) {
    const float t = x * (-2.302208198f - 0.102943240f * (x * x));
    return x * __builtin_amdgcn_rcpf(1.0f + __builtin_amdgcn_exp2f(t));
}
__device__ __forceinline__ f32x2 gelu_tanh2(f32x2 x) {
    const f32x2 t = x * ((x * x) * (-0.102943240f) + (-2.302208198f));
    f32x2 e; e.x = __builtin_amdgcn_exp2f(t.x); e.y = __builtin_amdgcn_exp2f(t.y);
    const f32x2 d = e + 1.0f;
    f32x2 r; r.x = __builtin_amdgcn_rcpf(d.x); r.y = __builtin_amdgcn_rcpf(d.y);
    return x * r;
}
__device__ __forceinline__ float sigmoid_f(float x) { return __builtin_amdgcn_rcpf(1.0f + __builtin_amdgcn_exp2f(-1.4426950409f * x)); }
__device__ __forceinline__ float dpp_ror1(float v) { const int x = __builtin_bit_cast(int, v); return __builtin_bit_cast(float, __builtin_amdgcn_update_dpp(x, x, 0x121, 0xf, 0xf, false)); }
__device__ __forceinline__ float dpp_ror2(float v) { const int x = __builtin_bit_cast(int, v); return __builtin_bit_cast(float, __builtin_amdgcn_update_dpp(x, x, 0x122, 0xf, 0xf, false)); }
__device__ __forceinline__ float dpp_shr1_keep(float keep, float v) { return __builtin_bit_cast(float, __builtin_amdgcn_update_dpp(__builtin_bit_cast(int, keep), __builtin_bit_cast(int, v), 0x111, 0xf, 0xf, false)); }
__device__ __forceinline__ float dpp_shr2_keep(float keep, float v) { return __builtin_bit_cast(float, __builtin_amdgcn_update_dpp(__builtin_bit_cast(int, keep), __builtin_bit_cast(int, v), 0x112, 0xf, 0xf, false)); }

struct EpiP {
    static constexpr bool PERM = true, AFTER_DRAIN = false, MIDK = false, PREF = true;
    bf16_t* O; const float* rs1; PG8_LAS unsigned char* pf;
    __device__ __forceinline__ void pre(const Unit& u, int wid, int lane) const {
        if (wid == 0) __builtin_amdgcn_global_load_lds((const unsigned*)(rs1 + u.pm * BM + 4 * lane), (PG8_LAS unsigned*)pf, 16, 0, 0);
    }
    __device__ __forceinline__ void operator()(const f32x4 (&acc)[2][2][4][2], const Unit& u, int wr, int wc, int fr, int fq) const {
        const int row0 = u.pm * BM + wr * 64 + fr, col0 = u.pn * BM + wc * 32 + 8 * fq;
        const bool act = u.pn < 12;
        float rs[2][4];
#pragma unroll
        for (int ai = 0; ai < 2; ++ai)
#pragma unroll
            for (int m = 0; m < 4; ++m) rs[ai][m] = *(const PG8_LAS float*)(pf + 4 * (wr * 64 + fr + ai * HALF + m * 16));
#pragma unroll
        for (int ai = 0; ai < 2; ++ai)
#pragma unroll
            for (int m = 0; m < 4; ++m) { bf16_t* rowp = O + (size_t)(row0 + ai * HALF + m * 16) * 4096 + col0;
#pragma unroll
                for (int bj = 0; bj < 2; ++bj) { f32x4 v0 = acc[ai][bj][m][0] * rs[ai][m], v1 = acc[ai][bj][m][1] * rs[ai][m];
                    if (act) { const f32x2 a0 = gelu_tanh2((f32x2){v0[0], v0[1]}), a1 = gelu_tanh2((f32x2){v0[2], v0[3]}), b0 = gelu_tanh2((f32x2){v1[0], v1[1]}), b1 = gelu_tanh2((f32x2){v1[2], v1[3]});
                        v0 = (f32x4){a0.x, a0.y, a1.x, a1.y}; v1 = (f32x4){b0.x, b0.y, b1.x, b1.y}; }
                    u32x4 w; w.x = cvt_pk_bf16(v0[0], v0[1]); w.y = cvt_pk_bf16(v0[2], v0[3]); w.z = cvt_pk_bf16(v1[0], v1[1]); w.w = cvt_pk_bf16(v1[2], v1[3]);
                    *(u32x4*)(rowp + bj * HALF) = w; } }
    }
};
template <bool RBF, bool MID> struct EpiRes {
    static constexpr bool PERM = true, AFTER_DRAIN = false, MIDK = false, PREF = false;
    const float* xi; bf16_t* xb; float* ss; const float* rsg;
    __device__ __forceinline__ void mid(f32x4 (&acc)[2][2][4][2], const Unit& u, int wr, int wc, int fr, int fq) const {
        const int row0 = u.pm * BM + wr * 64 + fr;
#pragma unroll
        for (int ai = 0; ai < 2; ++ai)
#pragma unroll
            for (int m = 0; m < 4; ++m) { const float s = rsg[row0 + ai * HALF + m * 16];
#pragma unroll
                for (int bj = 0; bj < 2; ++bj)
#pragma unroll
                    for (int n = 0; n < 2; ++n) acc[ai][bj][m][n] = acc[ai][bj][m][n] * s; }
    }
    __device__ __forceinline__ void operator()(const f32x4 (&acc)[2][2][4][2], const Unit& u, int wr, int wc, int fr, int fq) const {
        const int row0 = u.pm * BM + wr * 64 + fr, col0 = u.pn * BM + wc * 32 + 8 * fq;
#pragma unroll
        for (int ai = 0; ai < 2; ++ai) {
            u32x4 rb[4][2]; f32x4 rf[4][2][2]; float sc[4];
#pragma unroll
            for (int m = 0; m < 4; ++m) sc[m] = MID ? rsg[row0 + ai * HALF + m * 16] : 1.0f;
#pragma unroll
            for (int m = 0; m < 4; ++m)
#pragma unroll
                for (int bj = 0; bj < 2; ++bj) { const size_t o = (size_t)(row0 + ai * HALF + m * 16) * 2048 + col0 + bj * HALF;
                    if (RBF) rb[m][bj] = *(const u32x4*)(xb + o); else { rf[m][bj][0] = *(const f32x4*)(xi + o); rf[m][bj][1] = *(const f32x4*)(xi + o + 4); } }
#pragma unroll
            for (int m = 0; m < 4; ++m) { const int row = row0 + ai * HALF + m * 16; const size_t off = (size_t)row * 2048 + col0; float s = 0.f;
#pragma unroll
                for (int bj = 0; bj < 2; ++bj) { f32x4 r0, r1;
                    if (RBF) { const u32x4 rw = rb[m][bj]; r0 = (f32x4){bf_lo(rw.x), bf_hi(rw.x), bf_lo(rw.y), bf_hi(rw.y)}; r1 = (f32x4){bf_lo(rw.z), bf_hi(rw.z), bf_lo(rw.w), bf_hi(rw.w)}; } else { r0 = rf[m][bj][0]; r1 = rf[m][bj][1]; }
                    const f32x4 v0 = MID ? r0 + acc[ai][bj][m][0] * sc[m] : r0 + acc[ai][bj][m][0], v1 = MID ? r1 + acc[ai][bj][m][1] * sc[m] : r1 + acc[ai][bj][m][1];
                    s += ((v0[0] * v0[0] + v0[1] * v0[1]) + (v0[2] * v0[2] + v0[3] * v0[3])) + ((v1[0] * v1[0] + v1[1] * v1[1]) + (v1[2] * v1[2] + v1[3] * v1[3]));
                    u32x4 w; w.x = cvt_pk_bf16(v0[0], v0[1]); w.y = cvt_pk_bf16(v0[2], v0[3]); w.z = cvt_pk_bf16(v1[0], v1[1]); w.w = cvt_pk_bf16(v1[2], v1[3]); *(u32x4*)(xb + off + bj * HALF) = w; }
                s += __shfl_xor(s, 16); s += __shfl_xor(s, 32);
                if (fq == 0) unsafeAtomicAdd(ss + row, s); }
            asm volatile("" ::: "memory");
        }
    }
};
struct EpiUp {
    static constexpr bool PERM = true, AFTER_DRAIN = false, MIDK = false, PREF = true;
    const float* ss2; const float* cw; const float* cb; bf16_t* act; float* halo; PG8_LAS unsigned char* pf;
    __device__ __forceinline__ void pre(const Unit& u, int wid, int lane) const {
        if (wid == 0) __builtin_amdgcn_global_load_lds((const unsigned*)(ss2 + u.pm * BM + 4 * lane), (PG8_LAS unsigned*)pf, 16, 0, 0);
        else if (wid <= 4) { const int p = 2 * (wid - 1) + (lane >> 5), c = u.pn * 128 + 4 * (lane & 31);
            const float* base = (p & 3) == 3 ? cb : cw + 12288 * (p & 3);
            __builtin_amdgcn_global_load_lds((const unsigned*)(base + (p >> 2) * 6144 + c), (PG8_LAS unsigned*)(pf + 1024 + 1024 * (wid - 1)), 16, 0, 0); }
    }
    __device__ __forceinline__ void operator()(const f32x4 (&acc)[2][2][4][2], const Unit& u, int wr, int wc, int fr, int fq) const {
        const int rbase = u.pm * BM + wr * 128 + fr, grp = u.pm * 2 + wr;
        const int ca = u.pn * 128 + wc * 32 + 8 * fq;
        const bool l15 = fr == 15, l14 = fr >= 14;
        float rs[2][4];
#pragma unroll
        for (int ai = 0; ai < 2; ++ai)
#pragma unroll
            for (int m = 0; m < 4; ++m) rs[ai][m] = __builtin_amdgcn_rsqf(*(const PG8_LAS float*)(pf + 4 * (wr * 128 + fr + 64 * ai + 16 * m)) * (1.0f / 2048.0f) + 1e-6f);
        f32x4 pw[2][8];
#pragma unroll
        for (int n = 0; n < 2; ++n) { const int cl = wc * 32 + 8 * fq + 4 * n;
#pragma unroll
            for (int p = 0; p < 8; ++p) pw[n][p] = *(const PG8_LAS f32x4*)(pf + 1024 + 512 * p + 4 * cl); }
        f32x4 pg[2], pv[2];
        pg[0] = (f32x4){0.f, 0.f, 0.f, 0.f}; pg[1] = pg[0]; pv[0] = pg[0]; pv[1] = pg[0];
#pragma unroll
        for (int ai = 0; ai < 2; ++ai)
#pragma unroll
            for (int m = 0; m < 4; ++m) {
                const int q = 64 * ai + 16 * m + fr; u32x4 w;
#pragma unroll
                for (int n = 0; n < 2; ++n) {
                    const f32x4 g = acc[ai][0][m][n] * rs[ai][m], v = acc[ai][1][m][n] * rs[ai][m];
                    f32x4 g1, g2, v1, v2;
#pragma unroll
                    for (int j = 0; j < 4; ++j) {
                        g1[j] = dpp_ror1(l15 ? pg[n][j] : g[j]); g2[j] = dpp_ror2(l14 ? pg[n][j] : g[j]);
                        v1[j] = dpp_ror1(l15 ? pv[n][j] : v[j]); v2[j] = dpp_ror2(l14 ? pv[n][j] : v[j]); }
                    const f32x4 cgv = pw[n][3] + pw[n][2] * g + pw[n][1] * g1 + pw[n][0] * g2, cvv = pw[n][7] + pw[n][6] * v + pw[n][5] * v1 + pw[n][4] * v2;
                    const f32x2 o01 = gelu_tanh2((f32x2){cgv[0], cgv[1]}) * (f32x2){cvv[0], cvv[1]}, o23 = gelu_tanh2((f32x2){cgv[2], cgv[3]}) * (f32x2){cvv[2], cvv[3]};
                    const unsigned lo = cvt_pk_bf16(o01.x, o01.y), hi = cvt_pk_bf16(o23.x, o23.y);
                    if (n == 0) { w.x = lo; w.y = hi; } else { w.z = lo; w.w = hi; }
                    if ((ai == 0 && m == 0) || (ai == 1 && m == 3)) {
                        if (q < 2 || q >= 126) { const int slot = q < 2 ? q : q - 124; float* hp = halo + ((size_t)(grp * 4 + slot) * 2) * 6144 + ca + 4 * n;
                            *(f32x4*)hp = g; *(f32x4*)(hp + 6144) = v; } }
                    pg[n] = g; pv[n] = v;
                }
                if (q >= 2) *(u32x4*)(act + (size_t)(rbase + 64 * ai + 16 * m) * 6144 + ca) = w;
            }
    }
};

template <class Epi, class Sched, bool ALIGN_EPI = false, bool SP2 = false, bool APERM = false>
__device__ __forceinline__ void gemm_phase(PG8_LAS unsigned char* lds, const Gemm g, const Sched& S, const Epi& E, const int wid) {
    const int lane = (int)__builtin_amdgcn_mbcnt_hi(~0u, __builtin_amdgcn_mbcnt_lo(~0u, 0u)), tid = wid * 64 + lane, wr = wid >> 2, wc = wid & 3, fr = lane & 15, fq = lane >> 4;
    const int K = g.K, nt = K / BK;
    unsigned voffA[2], voffB[2];
#pragma unroll
    for (int i = 0; i < 2; ++i) { int R, C; stage_rc(tid * 16 + i * 8192, R, C); const int Rb = Epi::PERM ? ((R & ~31) + perm32(R & 31)) : R;
        const int Ra = APERM ? (R + 64 * (R >> 6)) : R; voffA[i] = (unsigned)(Ra * K + C) * 2u; voffB[i] = (unsigned)(Rb * K + C) * 2u; }
    const size_t kstep = (size_t)(BK * 2);
    const size_t hstep = (size_t)HALF * K * 2;
    const size_t hstepA = APERM ? (size_t)64 * K * 2 : hstep;
    const size_t tstep = 2 * hstep;
    const unsigned ldsw = (unsigned)wid * 1024u;
    const int aoff = lds_byte(wr * 64 + fr, fq * 8), boff = lds_byte(wc * 32 + fr, fq * 8);
#define PG8_SA(b, h) (((b) * 2 + (h)) * HTB)
#define PG8_SB(b, h) ((4 + (b) * 2 + (h)) * HTB)
#define PG8_STAGE(bufoff, gbase, voff) do { _Pragma("unroll") for (int _i = 0; _i < 2; ++_i) \
        __builtin_amdgcn_global_load_lds((const unsigned*)((const char*)(gbase) + (voff)[_i]), (PG8_LAS unsigned*)(lds + (bufoff) + ldsw + _i * 8192), 16, 0, 0); } while (0)
#define PG8_LDA(dst, b, h) do { _Pragma("unroll") for (int m = 0; m < 4; ++m) _Pragma("unroll") for (int k = 0; k < 2; ++k) dst[m][k] = *(const PG8_LAS bf16x8*)(lds + PG8_SA(b, h) + aoff + m * 2048 + k * 1024); } while (0)
#define PG8_LDB(dst, b, h) do { _Pragma("unroll") for (int n = 0; n < 2; ++n) _Pragma("unroll") for (int k = 0; k < 2; ++k) dst[n][k] = *(const PG8_LAS bf16x8*)(lds + PG8_SB(b, h) + boff + n * 2048 + k * 1024); } while (0)
#define PG8_MMA(ai, bj, At, Bt) do { __builtin_amdgcn_s_setprio(1); _Pragma("unroll") for (int m = 0; m < 4; ++m) _Pragma("unroll") for (int n = 0; n < 2; ++n) _Pragma("unroll") for (int k = 0; k < 2; ++k) \
        acc[ai][bj][m][n] = __builtin_amdgcn_mfma_f32_16x16x32_bf16(Bt[n][k], At[m][k], acc[ai][bj][m][n], 0, 0, 0); __builtin_amdgcn_s_setprio(0); } while (0)
#define PG8_WAIT_V(n) asm volatile("s_waitcnt vmcnt(" #n ")" ::: "memory")
#define PG8_WAIT_L(n) asm volatile("s_waitcnt lgkmcnt(" #n ")" ::: "memory")
#define PG8_BAR __builtin_amdgcn_s_barrier()
#define PG8_SCHED __builtin_amdgcn_sched_barrier(0)
    Unit cur, nxt; int ui = 0;
    if (!S.next(0, cur)) return;
    f32x4 acc[2][2][4][2];
#pragma unroll
    for (int a = 0; a < 2; ++a)
#pragma unroll
        for (int b = 0; b < 2; ++b)
#pragma unroll
            for (int m = 0; m < 4; ++m)
#pragma unroll
                for (int n = 0; n < 2; ++n) acc[a][b][m][n] = (f32x4){0.f, 0.f, 0.f, 0.f};
    bf16x8 At[4][2], B0[2][2], B1[2][2];
    const char* cA = (const char*)g.A + (size_t)cur.pm * tstep; const char* cB = (const char*)g.Bt + (size_t)cur.pn * tstep;
    S.a_ready(cur);
    if constexpr (SP2) {
        PG8_STAGE(PG8_SB(0, 0), cB, voffB); PG8_STAGE(PG8_SB(0, 1), cB + hstep, voffB); PG8_STAGE(PG8_SA(0, 0), cA, voffA); PG8_STAGE(PG8_SA(0, 1), cA + hstepA, voffA);
        if (wr == 1) PG8_BAR;
        PG8_WAIT_V(2); PG8_BAR;
        PG8_STAGE(PG8_SB(1, 0), cB + kstep, voffB); PG8_STAGE(PG8_SA(1, 0), cA + kstep, voffA); PG8_STAGE(PG8_SB(1, 1), cB + hstep + kstep, voffB);
        PG8_WAIT_V(6); PG8_BAR;
    } else {
        PG8_STAGE(PG8_SB(0, 0), cB, voffB); PG8_STAGE(PG8_SA(0, 0), cA, voffA); PG8_STAGE(PG8_SB(0, 1), cB + hstep, voffB); PG8_STAGE(PG8_SA(0, 1), cA + hstepA, voffA);
        if (wr == 1) PG8_BAR;
        PG8_WAIT_V(4); PG8_BAR;
        PG8_STAGE(PG8_SB(1, 0), cB + kstep, voffB); PG8_STAGE(PG8_SA(1, 0), cA + kstep, voffA); PG8_STAGE(PG8_SB(1, 1), cB + hstep + kstep, voffB);
        PG8_WAIT_V(6); PG8_BAR;
    }
    for (;;) {
        const bool has_next = S.next(ui + 1, nxt);
        const char* nA = has_next ? (const char*)g.A + (size_t)nxt.pm * tstep : cA; const char* nB = has_next ? (const char*)g.Bt + (size_t)nxt.pn * tstep : cB;
        for (int t = 0; t < nt; t += 2) {
            const bool last = (t == nt - 2);
            const char* a1 = cA + (size_t)(t + 1) * kstep;
            const char* a2 = last ? nA : cA + (size_t)(t + 2) * kstep; const char* b2 = last ? nB : cB + (size_t)(t + 2) * kstep;
            const char* a3 = a2 + kstep; const char* b3 = b2 + kstep;
            if (last && has_next) S.a_ready(nxt);
            if constexpr (Epi::PREF) { if (last) E.pre(cur, wid, lane); }
            if constexpr (Epi::MIDK) { if (t == nt / 2) E.mid(acc, cur, wr, wc, fr, fq); }
            if constexpr (SP2) {
            PG8_LDB(B0, 0, 0); PG8_LDB(B1, 0, 1); PG8_SCHED; PG8_LDA(At, 0, 0); PG8_STAGE(PG8_SA(1, 1), a1 + hstepA, voffA);
            PG8_WAIT_V(8); PG8_WAIT_L(0); PG8_BAR; PG8_MMA(0, 0, At, B0); PG8_MMA(0, 1, At, B1); PG8_BAR; PG8_SCHED;
            PG8_LDA(At, 0, 1); PG8_STAGE(PG8_SB(0, 0), b2, voffB); PG8_STAGE(PG8_SB(0, 1), b2 + hstep, voffB); PG8_STAGE(PG8_SA(0, 0), a2, voffA);
            PG8_WAIT_V(8); PG8_WAIT_L(0); PG8_BAR; PG8_MMA(1, 0, At, B0); PG8_MMA(1, 1, At, B1); PG8_BAR; PG8_SCHED;
            PG8_LDB(B0, 1, 0); PG8_LDB(B1, 1, 1); PG8_SCHED; PG8_LDA(At, 1, 0); PG8_STAGE(PG8_SA(0, 1), a2 + hstepA, voffA);
            PG8_WAIT_V(8); PG8_WAIT_L(0); PG8_BAR; PG8_MMA(0, 0, At, B0); PG8_MMA(0, 1, At, B1); PG8_BAR; PG8_SCHED;
            PG8_LDA(At, 1, 1); PG8_STAGE(PG8_SB(1, 0), b3, voffB); PG8_STAGE(PG8_SB(1, 1), b3 + hstep, voffB); PG8_STAGE(PG8_SA(1, 0), a3, voffA);
            PG8_WAIT_V(8); PG8_WAIT_L(0); PG8_BAR; PG8_MMA(1, 0, At, B0); PG8_MMA(1, 1, At, B1); PG8_BAR; PG8_SCHED;
            } else {
            PG8_LDB(B0, 0, 0); PG8_SCHED; PG8_LDA(At, 0, 0); PG8_STAGE(PG8_SA(1, 1), a1 + hstepA, voffA);
            PG8_WAIT_L(8); PG8_BAR; PG8_WAIT_L(0); PG8_MMA(0, 0, At, B0); PG8_BAR; PG8_SCHED;
            PG8_LDB(B1, 0, 1); PG8_STAGE(PG8_SB(0, 0), b2, voffB);
            PG8_BAR; PG8_WAIT_L(0); PG8_MMA(0, 1, At, B1); PG8_BAR;
            PG8_LDA(At, 0, 1); PG8_STAGE(PG8_SA(0, 0), a2, voffA);
            PG8_BAR; PG8_WAIT_L(0); PG8_MMA(1, 0, At, B0); PG8_BAR; PG8_SCHED;
            PG8_STAGE(PG8_SB(0, 1), b2 + hstep, voffB);
            PG8_WAIT_V(6); PG8_BAR; PG8_MMA(1, 1, At, B1); PG8_BAR;
            PG8_LDB(B0, 1, 0); PG8_SCHED; PG8_LDA(At, 1, 0); PG8_STAGE(PG8_SA(0, 1), a2 + hstepA, voffA);
            PG8_WAIT_L(8); PG8_BAR; PG8_WAIT_L(0); PG8_MMA(0, 0, At, B0); PG8_BAR; PG8_SCHED;
            PG8_LDB(B1, 1, 1); PG8_STAGE(PG8_SB(1, 0), b3, voffB);
            PG8_BAR; PG8_WAIT_L(0); PG8_MMA(0, 1, At, B1); PG8_BAR;
            PG8_LDA(At, 1, 1); PG8_STAGE(PG8_SA(1, 0), a3, voffA);
            PG8_BAR; PG8_WAIT_L(0); PG8_MMA(1, 0, At, B0); PG8_BAR; PG8_SCHED;
            PG8_STAGE(PG8_SB(1, 1), b3 + hstep, voffB);
            PG8_WAIT_V(6); PG8_BAR; PG8_MMA(1, 1, At, B1); PG8_BAR;
            }
        }
        if constexpr (ALIGN_EPI) { if (wr == 0) PG8_BAR; }
        if constexpr (!Epi::AFTER_DRAIN) { E(acc, cur, wr, wc, fr, fq); S.done(cur); }
        if (!has_next) break;
#pragma unroll
        for (int a = 0; a < 2; ++a)
#pragma unroll
            for (int b = 0; b < 2; ++b)
#pragma unroll
                for (int m = 0; m < 4; ++m)
#pragma unroll
                    for (int n = 0; n < 2; ++n) acc[a][b][m][n] = (f32x4){0.f, 0.f, 0.f, 0.f};
        cur = nxt; cA = nA; cB = nB; ++ui;
        if constexpr (ALIGN_EPI) { if (wr == 1) PG8_BAR; }
    }
    PG8_WAIT_V(0);
    if constexpr (!ALIGN_EPI) { if (wr == 0) PG8_BAR; }
    PG8_BAR;
    if constexpr (Epi::AFTER_DRAIN) { E.fused(acc, cur, wr, wc, fr, fq, lds, wid, lane); S.done(cur); }
#undef PG8_SA
#undef PG8_SB
#undef PG8_STAGE
#undef PG8_LDA
#undef PG8_LDB
#undef PG8_MMA
#undef PG8_WAIT_V
#undef PG8_WAIT_L
#undef PG8_BAR
#undef PG8_SCHED
}
}

#define LAS __attribute__((address_space(3)))
typedef unsigned short bf16;
typedef float f32x4 __attribute__((ext_vector_type(4)));
typedef float f32x2 __attribute__((ext_vector_type(2)));
typedef unsigned u32x4 __attribute__((ext_vector_type(4)));
typedef unsigned u32x2 __attribute__((ext_vector_type(2)));
typedef short bf16x8 __attribute__((ext_vector_type(8)));
using pg8::cvt_pk_bf16; using pg8::bf_lo; using pg8::bf_hi; using pg8::gelu_tanh; using pg8::sigmoid_f;

constexpr int NWAVES = 8, NTHREADS = 512;
constexpr int DM = 2048, NB = 4, SEQ = 8192, M = NB * SEQ;
constexpr int INC = 4096, DFF = 6144, NUP = 12288, NCHUNK = SEQ / 128, NTILE = M / 128;
constexpr float RMS_EPS = 1e-6f, LN_EPS = 1e-5f;
constexpr int LDS_BYTES = 155648;
constexpr int WSTRIDE = 17408;
constexpr int STATS_OFF = 8 * WSTRIDE;
constexpr int CARRYL_OFF = STATS_OFF + 1024;

constexpr size_t MiB = 1u << 20;
constexpr size_t WS_SS2 = 0, WS_RS1 = 512 * 1024, WS_RSG = 768 * 1024, WS_SS3 = 1 * MiB, WS_SSG = 2 * MiB  , WS_CARRY = 4 * MiB  ;
constexpr size_t WS_WM = 6 * MiB, WS_WAT = 6 * MiB + 256 * 1024, WS_WXT = 6 * MiB + 512 * 1024;
constexpr size_t WS_WIN = 7 * MiB, WS_WOUT = 23 * MiB, WS_WUP = 31 * MiB, WS_WDN = 79 * MiB;
constexpr size_t WS_X1B = 104 * MiB;
constexpr size_t WS_H1 = 256 * MiB, WS_Y = 256 * MiB, WS_P = 384 * MiB, WS_SC = 640 * MiB, WS_ACT = 256 * MiB, WS_HALO = 768 * MiB, WS_END = 816 * MiB;

struct Args { const float* in[23]; float* out; unsigned char* ws; int ph_lo, ph_hi; };
enum { I_X = 0, I_N1G, I_WIN, I_GVG, I_GVB, I_GWS, I_GBS, I_LCW, I_LCB, I_LWA, I_LBA, I_LWX, I_LBX, I_LAM, I_GOG, I_LOG, I_WOUT, I_N2G, I_WUP, I_FCW, I_FCB, I_WDN, I_FG };

__device__ __forceinline__ float wave_sum(float v) {
#pragma unroll
    for (int o = 1; o < 64; o <<= 1) v += __shfl_xor(v, o);
    return v;
}
#define LDS_WAIT() asm volatile("s_waitcnt lgkmcnt(0)" ::: "memory")
#define WAVE_SYNC() do { asm volatile("s_waitcnt lgkmcnt(0)" ::: "memory"); __builtin_amdgcn_wave_barrier(); } while (0)

__device__ __forceinline__ void transpose_item(const float* W, int K, int N, bf16* WT, int drow0, LAS float* scr  , int k0, int n0, int lane, const float* ks0, const float* ks1, int ksplit) {
    const int r4 = lane >> 4, c4 = (lane & 15) * 4;
#pragma unroll 8
    for (int i = 0; i < 16; ++i) { const int kk = 4 * i + r4, k = k0 + kk; f32x4 v = *(const f32x4*)(W + (size_t)k * N + n0 + c4);
        if (ks0) v = v * (k < ksplit ? ks0[k] : ks1[k - ksplit]);
        LAS float* d = scr + kk * 65 + c4; d[0] = v[0]; d[1] = v[1]; d[2] = v[2]; d[3] = v[3]; }
    LDS_WAIT(); __builtin_amdgcn_wave_barrier();
    const int c = lane & 7;
#pragma unroll
    for (int i = 0; i < 8; ++i) { const int n = (lane >> 3) + 8 * i; const LAS float* s = scr + (8 * c) * 65 + n;
        u32x4 o; o.x = cvt_pk_bf16(s[0 * 65], s[1 * 65]); o.y = cvt_pk_bf16(s[2 * 65], s[3 * 65]); o.z = cvt_pk_bf16(s[4 * 65], s[5 * 65]); o.w = cvt_pk_bf16(s[6 * 65], s[7 * 65]);
        *(u32x4*)(WT + (size_t)(drow0 + n) * K + k0 + 8 * c) = o; }
    LDS_WAIT(); __builtin_amdgcn_wave_barrier();
}

__device__ __forceinline__ void phase_prologue(const Args& a, LAS unsigned char* lds, int wave, int lane) {
    unsigned char* ws = a.ws;
    LAS float* scr = (LAS float*)(lds + wave * WSTRIDE);
    const int gw = blockIdx.x * NWAVES + wave, NGW = gridDim.x * NWAVES;
    const int gt = blockIdx.x * NTHREADS + wave * 64 + lane, NGT = gridDim.x * NTHREADS;
    { float* s2 = (float*)(ws + WS_SS2); float* s3 = (float*)(ws + WS_SS3); for (int i = gt; i < M; i += NGT) { s2[i] = 0.f; s3[i] = 0.f; } }
    { bf16* wm = (bf16*)(ws + WS_WM); bf16* wat = (bf16*)(ws + WS_WAT); bf16* wxt = (bf16*)(ws + WS_WXT);
      const float* gws = a.in[I_GWS]; const float* wa = a.in[I_LWA]; const float* wx = a.in[I_LWX];
      for (int i = gt; i < 8 * 128 * 128 / 2; i += NGT) { const int e = 2 * i, s = e & 127, t = (e >> 7) & 127;
          const float v0 = s <= t ? gws[e] : 0.f, v1 = (s + 1) <= t ? gws[e + 1] : 0.f; ((unsigned*)wm)[i] = cvt_pk_bf16(v0, v1);
          const int h = e >> 14, jj = (e >> 7) & 127, ii = e & 127;
          const size_t src = (size_t)h * 16384 + (size_t)ii * 128 + jj;
          ((unsigned*)wat)[i] = cvt_pk_bf16(wa[src], wa[src + 128]); ((unsigned*)wxt)[i] = cvt_pk_bf16(wx[src], wx[src + 128]); } }
    constexpr int IT_IN = (DM / 64) * (INC / 64), IT_OUT = (DM / 64) * (DM / 64), IT_UP = (DM / 64) * (NUP / 64), IT_DN = (DFF / 64) * (DM / 64);
    constexpr int NITEMS = IT_IN + IT_OUT + IT_UP + IT_DN;
    for (int it = gw; it < NITEMS; it += NGW) {
        int r = it;
        if (r < IT_IN) { const int nblk = INC / 64, kb = r / nblk, nb = r % nblk; transpose_item(a.in[I_WIN], DM, INC, (bf16*)(ws + WS_WIN), 64 * nb, scr, 64 * kb, 64 * nb, lane, a.in[I_N1G], a.in[I_N1G], DM); continue; } r -= IT_IN;
        if (r < IT_OUT) { const int nblk = DM / 64, kb = r / nblk, nb = r % nblk; transpose_item(a.in[I_WOUT], DM, DM, (bf16*)(ws + WS_WOUT), 64 * nb, scr, 64 * kb, 64 * nb, lane, a.in[I_GOG], a.in[I_LOG], 1024); continue; } r -= IT_OUT;
        if (r < IT_UP) { const int nblk = NUP / 64, kb = r / nblk, nb = r % nblk; const int n0 = 64 * nb, bj = n0 / DFF, aa = n0 % DFF, drow = 256 * (aa >> 7) + 128 * bj + (aa & 127);
            transpose_item(a.in[I_WUP], DM, NUP, (bf16*)(ws + WS_WUP), drow, scr, 64 * kb, n0, lane, a.in[I_N2G], a.in[I_N2G], DM); continue; } r -= IT_UP;
        { const int nblk = DM / 64, kb = r / nblk, nb = r % nblk; transpose_item(a.in[I_WDN], DFF, DM, (bf16*)(ws + WS_WDN), 64 * nb, scr, 64 * kb, 64 * nb, lane, nullptr, nullptr, 0); }
    }
    { bf16* XB = (bf16*)(ws + WS_X1B); float* RS1 = (float*)(ws + WS_RS1);
      for (int m = gw; m < M; m += NGW) { const f32x4* xr = (const f32x4*)(a.in[I_X] + (size_t)m * DM) + lane; f32x4 v[8]; float s = 0.f;
#pragma unroll
          for (int j = 0; j < 8; ++j) { v[j] = xr[64 * j]; s += (v[j][0] * v[j][0] + v[j][1] * v[j][1]) + (v[j][2] * v[j][2] + v[j][3] * v[j][3]); }
          u32x2* o = (u32x2*)(XB + (size_t)m * DM) + lane;
#pragma unroll
          for (int j = 0; j < 8; ++j) { u32x2 w; w.x = cvt_pk_bf16(v[j][0], v[j][1]); w.y = cvt_pk_bf16(v[j][2], v[j][3]); o[64 * j] = w; }
          const float rs = __builtin_amdgcn_rsqf(wave_sum(s) * (1.0f / DM) + RMS_EPS);
          if (lane == 0) RS1[m] = rs; } }
}

__device__ __forceinline__ void lru_nt_scan(const f32x4 (&ar)[4], const f32x4 (&ax)[4], float bav, float bxv, float lam, LAS bf16* WL, LAS f32x2* carryL,
                                            unsigned* SCrow  , int nt, int fr, int fq) {
    const int jl = 16 * nt + fr;
    const f32x2 c0v = carryL[jl]; float cPn = c0v.x, cHn = c0v.y;
    const float spv = (fmaxf(-lam, 0.f) + __logf(1.0f + __expf(-fabsf(lam)))) * (8.0f * 1.4426950409f);
#pragma unroll
    for (int m = 0; m < 4; ++m) {
        float A[4], H[4];
#pragma unroll
        for (int r = 0; r < 4; ++r) { const float rr = sigmoid_f(ar[m][r] + bav), ii = sigmoid_f(ax[m][r] + bxv); const float av = __builtin_amdgcn_exp2f(-rr * spv);
            const float mult = __builtin_amdgcn_sqrtf(fmaxf(1.0f - av * av, 0.f)); const float xv = __builtin_bit_cast(float, (unsigned)WL[(16 * m + 4 * fq + r) * 136 + jl] << 16);
            const float bv = mult * ii * xv;
            if (r == 0) { A[0] = av; H[0] = bv; } else { A[r] = av * A[r - 1]; H[r] = av * H[r - 1] + bv; } }
        float xA = A[3], xH = H[3];
        float yA = __shfl_up(xA, 16), yH = __shfl_up(xH, 16); if (fq >= 1) { xH = xA * yH + xH; xA = xA * yA; }
        yA = __shfl_up(xA, 32); yH = __shfl_up(xH, 32); if (fq >= 2) { xH = xA * yH + xH; xA = xA * yA; }
        float eA = __shfl_up(xA, 16), eH = __shfl_up(xH, 16); if (fq == 0) { eA = 1.f; eH = 0.f; }
        const float pA = cPn * eA, pH = eA * cHn + eH;
#pragma unroll
        for (int r = 0; r < 4; ++r) { const float Pr = pA * A[r], hr = A[r] * pH + H[r]; SCrow[(size_t)(16 * m + 4 * fq + r) * 1024 + jl] = cvt_pk_bf16(hr, Pr); }
        const float tA = __shfl(xA, fr + 48), tH = __shfl(xH, fr + 48);
        cHn = tA * cHn + tH; cPn = cPn * tA;
    }
    if (fq == 0) carryL[jl] = (f32x2){cPn, cHn};
}

__device__ __forceinline__ void phase_mixer(const Args& a, LAS unsigned char* lds, int wave, int lane) {
    unsigned char* ws = a.ws;
    const bf16* P = (const bf16*)(ws + WS_P); bf16* Y = (bf16*)(ws + WS_Y); unsigned* SC = (unsigned*)(ws + WS_SC);
    float* SSG = (float*)(ws + WS_SSG); float* CARRY = (float*)(ws + WS_CARRY);
    const bf16* WMK = (const bf16*)(ws + WS_WM); const bf16* WAT = (const bf16*)(ws + WS_WAT); const bf16* WXT = (const bf16*)(ws + WS_WXT);
    const int fr = lane & 15, fq = lane >> 4, h = wave;
    LAS f32x2* stats = (LAS f32x2*)(lds + STATS_OFF);
    LAS bf16* WL = (LAS bf16*)(lds + wave * WSTRIDE);
    for (int tile = blockIdx.x; tile < NTILE; tile += gridDim.x) {
        const int ch = tile & (NCHUNK - 1); const size_t row0 = (size_t)tile * 128;
#pragma unroll 1
        for (int bt = 0; bt < 2; ++bt) {
            u32x4 r0[8], r1[8];
#pragma unroll
            for (int i = 0; i < 8; ++i) { const bf16* vr = P + (row0 + wave * 16 + bt * 8 + i) * INC + 1024; r0[i] = *(const u32x4*)(vr + lane * 8); r1[i] = *(const u32x4*)(vr + 512 + lane * 8); }
#pragma unroll
            for (int i = 0; i < 8; ++i) { float s = 0.f, q = 0.f;
#pragma unroll
                for (int k = 0; k < 4; ++k) { const float f0 = bf_lo(r0[i][k]), f1 = bf_hi(r0[i][k]), f2 = bf_lo(r1[i][k]), f3 = bf_hi(r1[i][k]); s += (f0 + f1) + (f2 + f3); q += (f0 * f0 + f1 * f1) + (f2 * f2 + f3 * f3); }
                s = wave_sum(s); q = wave_sum(q); const float mean = s * (1.0f / 1024.0f), var = q * (1.0f / 1024.0f) - mean * mean;
                if (lane == 0) stats[wave * 16 + bt * 8 + i] = (f32x2){mean, __builtin_amdgcn_rsqf(var + LN_EPS)}; }
        }
        __syncthreads();
#pragma unroll 1
        for (int hh = 0; hh < 2; ++hh) {
            const int cbase = 128 * h + 64 * hh;
            u32x2 U[4][4]; float bst[4];
#pragma unroll
            for (int m = 0; m < 4; ++m) { bst[m] = a.in[I_GBS][h * 128 + 16 * m + fr];
#pragma unroll
                for (int n = 0; n < 4; ++n) U[m][n] = *(const u32x2*)(P + (row0 + 16 * m + fr) * INC + cbase + 16 * n + 4 * fq); }
            { const int cgp = lane & 7, tg = lane >> 3, c0 = 8 * cgp;
              float gv[8], bv[8];
#pragma unroll
              for (int j = 0; j < 8; ++j) { gv[j] = a.in[I_GVG][cbase + c0 + j]; bv[j] = a.in[I_GVB][cbase + c0 + j]; }
#pragma unroll 1
              for (int task = 0; task < 2; ++task) { const int s0 = 8 * (tg + 8 * task);
                  float vals[8][8];
#pragma unroll
                  for (int s = 0; s < 8; ++s) { const u32x4 raw = *(const u32x4*)(P + (row0 + s0 + s) * INC + 1024 + cbase + c0); const f32x2 st = stats[s0 + s];
#pragma unroll
                      for (int k = 0; k < 4; ++k) { vals[s][2 * k] = (bf_lo(raw[k]) - st.x) * st.y * gv[2 * k] + bv[2 * k]; vals[s][2 * k + 1] = (bf_hi(raw[k]) - st.x) * st.y * gv[2 * k + 1] + bv[2 * k + 1]; } }
#pragma unroll
                  for (int j = 0; j < 8; ++j) { u32x4 w; w.x = cvt_pk_bf16(vals[0][j], vals[1][j]); w.y = cvt_pk_bf16(vals[2][j], vals[3][j]); w.z = cvt_pk_bf16(vals[4][j], vals[5][j]); w.w = cvt_pk_bf16(vals[6][j], vals[7][j]);
                      *(LAS u32x4*)(WL + (c0 + j) * 136 + s0) = w; } } }
            WAVE_SYNC();
            bf16x8 Af[2][4];
            Af[0][0] = *(const bf16x8*)(WMK + ((size_t)h * 128 + fr) * 128 + 8 * fq);
#pragma unroll 1
            for (int mh = 0; mh < 2; ++mh) {
                if (mh == 1) {
#pragma unroll
                    for (int m = 0; m < 4; ++m) { bst[m] = a.in[I_GBS][h * 128 + 64 + 16 * m + fr];
#pragma unroll
                        for (int n = 0; n < 4; ++n) U[m][n] = *(const u32x2*)(P + (row0 + 64 + 16 * m + fr) * INC + cbase + 16 * n + 4 * fq); } }
#pragma unroll
                for (int mi = 0; mi < 4; ++mi) {
                    const int m = 4 * mh + mi, kcur = m >> 1, knext = (m + 1) >> 1;
                    if (m < 7) {
#pragma unroll
                        for (int ks = 0; ks < 4; ++ks) if (ks <= knext) Af[(mi + 1) & 1][ks] = *(const bf16x8*)(WMK + ((size_t)h * 128 + 16 * (m + 1) + fr) * 128 + 32 * ks + 8 * fq); }
                    f32x4 acc[4];
#pragma unroll
                    for (int n = 0; n < 4; ++n) acc[n] = (f32x4){0.f, 0.f, 0.f, 0.f};
#pragma unroll
                    for (int ks = 0; ks < 4; ++ks) if (ks <= kcur) {
#pragma unroll
                        for (int n = 0; n < 4; ++n) { const bf16x8 Bf = *(const LAS bf16x8*)(WL + (16 * n + fr) * 136 + 32 * ks + 8 * fq); acc[n] = __builtin_amdgcn_mfma_f32_16x16x32_bf16(Bf, Af[mi & 1][ks], acc[n], 0, 0, 0); } }
                    const int t = 16 * m + fr; float sq = 0.f;
#pragma unroll
                    for (int n = 0; n < 4; ++n) { const int cc = cbase + 16 * n + 4 * fq; const u32x2 uu = U[mi][n];
                        const float y0 = bf_lo(uu.x) * (acc[n][0] + bst[mi]), y1 = bf_hi(uu.x) * (acc[n][1] + bst[mi]), y2 = bf_lo(uu.y) * (acc[n][2] + bst[mi]), y3 = bf_hi(uu.y) * (acc[n][3] + bst[mi]);
                        sq += (y0 * y0 + y1 * y1) + (y2 * y2 + y3 * y3); u32x2 w; w.x = cvt_pk_bf16(y0, y1); w.y = cvt_pk_bf16(y2, y3); *(u32x2*)(Y + (row0 + t) * DM + cc) = w; }
                    sq += __shfl_xor(sq, 16); sq += __shfl_xor(sq, 32); if (fq == 0) SSG[(row0 + t) * 16 + 2 * h + hh] = sq;
                    asm volatile("" ::: "memory");
                }
            }
            WAVE_SYNC();
        }
        LAS f32x2* carryL = (LAS f32x2*)(lds + CARRYL_OFF + wave * 1024);
        carryL[lane] = (f32x2){1.f, 0.f}; carryL[64 + lane] = (f32x2){1.f, 0.f};
#pragma unroll 1
        for (int hf = 0; hf < 2; ++hf) {
            const int t0 = 64 * hf;
            { const int cgp = lane & 15, tg = lane >> 4, c0 = 8 * cgp, jc = 128 * h + c0, ts = t0 + 16 * tg;
              const bf16* xp = P + (row0 + ts) * INC + 3072 + jc;
              const bool hasprev = (ch * 128 + ts) > 0;
              u32x4 rows[19];
#pragma unroll
              for (int tt = 0; tt < 16; ++tt) rows[3 + tt] = *(const u32x4*)(xp + (size_t)tt * INC);
              rows[0] = (u32x4){0u, 0u, 0u, 0u}; rows[1] = rows[0]; rows[2] = rows[0];
              if (hasprev) { rows[0] = *(const u32x4*)(xp - 3 * INC); rows[1] = *(const u32x4*)(xp - 2 * INC); rows[2] = *(const u32x4*)(xp - INC); }
              float w0[8], w1[8], w2[8], w3[8], cbv[8];
#pragma unroll
              for (int j = 0; j < 8; ++j) { w0[j] = a.in[I_LCW][jc + j]; w1[j] = a.in[I_LCW][1024 + jc + j]; w2[j] = a.in[I_LCW][2048 + jc + j]; w3[j] = a.in[I_LCW][3072 + jc + j]; cbv[j] = a.in[I_LCB][jc + j]; }
#pragma unroll
              for (int tt = 0; tt < 16; ++tt) { u32x4 w;
#pragma unroll
                  for (int k = 0; k < 4; ++k) {
                      const float lo = cbv[2 * k] + w0[2 * k] * bf_lo(rows[tt][k]) + w1[2 * k] * bf_lo(rows[tt + 1][k]) + w2[2 * k] * bf_lo(rows[tt + 2][k]) + w3[2 * k] * bf_lo(rows[tt + 3][k]);
                      const float hi = cbv[2 * k + 1] + w0[2 * k + 1] * bf_hi(rows[tt][k]) + w1[2 * k + 1] * bf_hi(rows[tt + 1][k]) + w2[2 * k + 1] * bf_hi(rows[tt + 2][k]) + w3[2 * k + 1] * bf_hi(rows[tt + 3][k]);
                      w[k] = cvt_pk_bf16(lo, hi); }
                  *(LAS u32x4*)(WL + (16 * tg + tt) * 136 + c0) = w; } }
            WAVE_SYNC();
            bf16x8 Af[4][4];
#pragma unroll
            for (int m = 0; m < 4; ++m)
#pragma unroll
                for (int ks = 0; ks < 4; ++ks) Af[m][ks] = *(const LAS bf16x8*)(WL + (16 * m + fr) * 136 + 32 * ks + 8 * fq);
            unsigned* SCrow = SC + (row0 + t0) * 1024 + 128 * h;
            const bf16* wa_l = WAT + ((size_t)h * 128 + fr) * 128 + 8 * fq; const bf16* wx_l = WXT + ((size_t)h * 128 + fr) * 128 + 8 * fq;
            const float* pba = a.in[I_LBA] + 128 * h + fr; const float* pbx = a.in[I_LBX] + 128 * h + fr; const float* plm = a.in[I_LAM] + 128 * h + fr;
            bf16x8 Ba[4], Bx[4]; float q0[3];
#pragma unroll
            for (int ks = 0; ks < 4; ++ks) { Ba[ks] = *(const bf16x8*)(wa_l + 32 * ks); Bx[ks] = *(const bf16x8*)(wx_l + 32 * ks); }
            q0[0] = pba[0]; q0[1] = pbx[0]; q0[2] = plm[0];
#pragma unroll 1
            for (int nt = 0; nt < 8; ++nt) {
                f32x4 ar[4], ax[4];
#pragma unroll
                for (int m = 0; m < 4; ++m) { ar[m] = (f32x4){0.f, 0.f, 0.f, 0.f}; ax[m] = ar[m]; }
#pragma unroll
                for (int ks = 0; ks < 4; ++ks)
#pragma unroll
                    for (int m = 0; m < 4; ++m) { ar[m] = __builtin_amdgcn_mfma_f32_16x16x32_bf16(Af[m][ks], Ba[ks], ar[m], 0, 0, 0); ax[m] = __builtin_amdgcn_mfma_f32_16x16x32_bf16(Af[m][ks], Bx[ks], ax[m], 0, 0, 0); }
                const float c_ba = q0[0], c_bx = q0[1], c_lm = q0[2];
                const int nn = (nt + 1) & 7;
#pragma unroll
                for (int ks = 0; ks < 4; ++ks) { Ba[ks] = *(const bf16x8*)(wa_l + nn * 2048 + 32 * ks); Bx[ks] = *(const bf16x8*)(wx_l + nn * 2048 + 32 * ks); }
                q0[0] = pba[16 * nn]; q0[1] = pbx[16 * nn]; q0[2] = plm[16 * nn];
                lru_nt_scan(ar, ax, c_ba, c_bx, c_lm, WL, carryL, SCrow, nt, fr, fq);
            }
            WAVE_SYNC();
        }
        *(f32x2*)(CARRY + ((size_t)tile * 1024 + 128 * h + lane) * 2) = carryL[lane]; *(f32x2*)(CARRY + ((size_t)tile * 1024 + 128 * h + 64 + lane) * 2) = carryL[64 + lane];
        __syncthreads();
    }
}

__device__ __forceinline__ void phase_mixer2(const Args& a, LAS unsigned char* lds, int wave, int lane) {
    unsigned char* ws = a.ws;
    const bf16* P = (const bf16*)(ws + WS_P); bf16* Y = (bf16*)(ws + WS_Y); const unsigned* SC = (const unsigned*)(ws + WS_SC);
    const float* SSG = (const float*)(ws + WS_SSG); const float* CARRY = (const float*)(ws + WS_CARRY); float* RSG = (float*)(ws + WS_RSG);
    LAS float* carry = (LAS float*)lds;
    for (int tile = blockIdx.x; tile < NTILE; tile += gridDim.x) {
        const int b = tile >> 6, ch = tile & (NCHUNK - 1); const size_t row0 = (size_t)tile * 128;
        { const int j = wave * 64 + lane; const float* cp = CARRY + ((size_t)(b * NCHUNK) * 1024 + j) * 2;
          float ca = 0.f, cb = 0.f; int cc = 0;
          for (; cc + 8 <= ch; cc += 8) { f32x2 ea[8], eb[8];
#pragma unroll
              for (int u = 0; u < 8; ++u) { ea[u] = *(const f32x2*)(cp + (size_t)(cc + u) * 2048); eb[u] = *(const f32x2*)(cp + (size_t)(cc + u) * 2048 + 1024); }
#pragma unroll
              for (int u = 0; u < 8; ++u) { ca = ea[u].x * ca + ea[u].y; cb = eb[u].x * cb + eb[u].y; } }
          for (; cc < ch; ++cc) { const f32x2 ea = *(const f32x2*)(cp + (size_t)cc * 2048), eb = *(const f32x2*)(cp + (size_t)cc * 2048 + 1024); ca = ea.x * ca + ea.y; cb = eb.x * cb + eb.y; }
          carry[j] = ca; carry[j + 512] = cb; }
        __syncthreads();
        float cr[16];
#pragma unroll
        for (int k = 0; k < 8; ++k) { cr[k] = carry[8 * lane + k]; cr[8 + k] = carry[512 + 8 * lane + k]; }
#pragma unroll 1
        for (int i = 0; i < 16; i += 2) {
            u32x4 s0[2], s1[2], s2[2], s3[2], g0[2], g1[2]; f32x4 qq[2][4];
#pragma unroll
            for (int r = 0; r < 2; ++r) { const size_t row = row0 + 16 * wave + i + r;
                const unsigned* scp = SC + row * 1024 + 8 * lane; s0[r] = *(const u32x4*)scp; s1[r] = *(const u32x4*)(scp + 4); s2[r] = *(const u32x4*)(scp + 512); s3[r] = *(const u32x4*)(scp + 516);
                const bf16* gp = P + row * INC + 2048 + 8 * lane; g0[r] = *(const u32x4*)gp; g1[r] = *(const u32x4*)(gp + 512);
#pragma unroll
                for (int k = 0; k < 4; ++k) qq[r][k] = *(const f32x4*)(SSG + row * 16 + 4 * k); }
#pragma unroll
            for (int r = 0; r < 2; ++r) { const size_t row = row0 + 16 * wave + i + r;
                float y[16]; float q = 0.f;
#pragma unroll
                for (int k = 0; k < 8; ++k) { const unsigned sa = k < 4 ? s0[r][k & 3] : s1[r][k & 3], sb = k < 4 ? s2[r][k & 3] : s3[r][k & 3];
                    const unsigned ga = g0[r][k >> 1], gb = g1[r][k >> 1]; const float gva = (k & 1) ? bf_hi(ga) : bf_lo(ga), gvb = (k & 1) ? bf_hi(gb) : bf_lo(gb);
                    y[k] = (bf_lo(sa) + bf_hi(sa) * cr[k]) * gva; y[8 + k] = (bf_lo(sb) + bf_hi(sb) * cr[8 + k]) * gvb; q += y[k] * y[k] + y[8 + k] * y[8 + k]; }
                const f32x4 qs = (qq[r][0] + qq[r][1]) + (qq[r][2] + qq[r][3]); const float mg = ((qs[0] + qs[1]) + (qs[2] + qs[3])) * (1.0f / 1024.0f) + RMS_EPS;
                const float sg = __builtin_amdgcn_rsqf(mg);
                const float sl = __builtin_amdgcn_rsqf(wave_sum(q) * (1.0f / 1024.0f) + RMS_EPS) * __builtin_amdgcn_sqrtf(mg);
                u32x4 o0, o1;
#pragma unroll
                for (int k = 0; k < 4; ++k) { o0[k] = cvt_pk_bf16(y[2 * k] * sl, y[2 * k + 1] * sl); o1[k] = cvt_pk_bf16(y[8 + 2 * k] * sl, y[8 + 2 * k + 1] * sl); }
                bf16* yp = Y + row * DM + 8 * lane;
                *(u32x4*)(yp + 1024) = o0; *(u32x4*)(yp + 1024 + 512) = o1;
                if (lane == 0) RSG[row] = sg; }
        }
        __syncthreads();
    }
}

__device__ __forceinline__ void phase_fixup(const Args& a, int wave, int lane) {
    unsigned char* ws = a.ws; const float* halo = (const float*)(ws + WS_HALO); bf16* ACT = (bf16*)(ws + WS_ACT);
    const float* cw = a.in[I_FCW]; const float* cb = a.in[I_FCB];
    const int gt = blockIdx.x * NTHREADS + wave * 64 + lane, NGT = gridDim.x * NTHREADS;
    for (int idx = gt; idx < 256 * 2 * 1536; idx += NGT) { const int c = 4 * (idx % 1536), rr = (idx / 1536) & 1, g = idx / 3072; const bool first = (g & 63) == 0;
        const size_t row = (size_t)g * 128 + rr;
        f32x4 o[2];
#pragma unroll
        for (int bj = 0; bj < 2; ++bj) { const f32x4 z = (f32x4){0.f, 0.f, 0.f, 0.f};
            const f32x4 cur = *(const f32x4*)(halo + ((size_t)(g * 4 + rr) * 2 + bj) * 6144 + c);
            f32x4 p1, p2;
            if (rr == 0) { p1 = first ? z : *(const f32x4*)(halo + ((size_t)((g - 1) * 4 + 3) * 2 + bj) * 6144 + c); p2 = first ? z : *(const f32x4*)(halo + ((size_t)((g - 1) * 4 + 2) * 2 + bj) * 6144 + c); }
            else { p1 = *(const f32x4*)(halo + ((size_t)(g * 4 + 0) * 2 + bj) * 6144 + c); p2 = first ? z : *(const f32x4*)(halo + ((size_t)((g - 1) * 4 + 3) * 2 + bj) * 6144 + c); }
            const int pc = bj * DFF + c;
            o[bj] = *(const f32x4*)(cb + pc) + *(const f32x4*)(cw + 2 * NUP + pc) * cur + *(const f32x4*)(cw + NUP + pc) * p1 + *(const f32x4*)(cw + pc) * p2; }
        u32x2 w; w.x = cvt_pk_bf16(gelu_tanh(o[0][0]) * o[1][0], gelu_tanh(o[0][1]) * o[1][1]); w.y = cvt_pk_bf16(gelu_tanh(o[0][2]) * o[1][2], gelu_tanh(o[0][3]) * o[1][3]);
        *(u32x2*)(ACT + row * DFF + c) = w; }
}

__device__ __forceinline__ void phase_final(const Args& a, int wave, int lane) {
    const float* ss3 = (const float*)(a.ws + WS_SS3); const bf16* X2 = (const bf16*)(a.ws + WS_X1B);
    const int gw = blockIdx.x * NWAVES + wave, NGW = gridDim.x * NWAVES;
    f32x4 g[8];
#pragma unroll
    for (int j = 0; j < 4; ++j) { g[2 * j] = *(const f32x4*)(a.in[I_FG] + 512 * j + 8 * lane); g[2 * j + 1] = *(const f32x4*)(a.in[I_FG] + 512 * j + 8 * lane + 4); }
    for (int m = gw; m < M; m += 4 * NGW) {
        u32x4 v[4][4]; float rs[4];
#pragma unroll
        for (int r = 0; r < 4; ++r) { const bf16* xr = X2 + (size_t)(m + r * NGW) * DM + 8 * lane; rs[r] = ss3[m + r * NGW];
#pragma unroll
            for (int j = 0; j < 4; ++j) v[r][j] = *(const u32x4*)(xr + 512 * j); }
#pragma unroll
        for (int r = 0; r < 4; ++r) { const float s = __builtin_amdgcn_rsqf(rs[r] * (1.0f / DM) + RMS_EPS); float* orow = a.out + (size_t)(m + r * NGW) * DM + 8 * lane;
#pragma unroll
            for (int j = 0; j < 4; ++j) { const f32x4 lo = (f32x4){bf_lo(v[r][j][0]), bf_hi(v[r][j][0]), bf_lo(v[r][j][1]), bf_hi(v[r][j][1])}, hi = (f32x4){bf_lo(v[r][j][2]), bf_hi(v[r][j][2]), bf_lo(v[r][j][3]), bf_hi(v[r][j][3])};
                *(f32x4*)(orow + 512 * j) = lo * s * g[2 * j]; *(f32x4*)(orow + 512 * j + 4) = hi * s * g[2 * j + 1]; } } }
}

#ifndef MK_N_LAUNCHES
#define MK_N_LAUNCHES 1
#endif
constexpr int N_PHASES = 9;
__global__ void __launch_bounds__(NTHREADS, 2) hymba_fwd(Args a) {
    extern __shared__ __attribute__((aligned(16))) unsigned char lds_raw[];
    LAS unsigned char* lds = (LAS unsigned char*)lds_raw;
    cg::grid_group grid = cg::this_grid();
    const int wave = __builtin_amdgcn_readfirstlane(threadIdx.x >> 6);
#define LANE() ((int)__builtin_amdgcn_mbcnt_hi(~0u, __builtin_amdgcn_mbcnt_lo(~0u, 0u)))
    unsigned char* ws = a.ws;
    const int lo = a.ph_lo, hi = a.ph_hi;
#ifndef PH_MASK
#define PH_MASK 0x1ff
#endif
#define IN(k) (((PH_MASK >> (k)) & 1) && lo <= (k) && (k) < hi)
#ifndef REP_MASK
#define REP_MASK 0
#endif
#define REPS(k) for (int rep_ = 0; rep_ < 1 + ((REP_MASK >> (k)) & 1); ++rep_)
#define SEAM(k) do { if (IN(k) && IN((k) + 1)) grid.sync(); } while (0)
    if (IN(0)) REPS(0) { phase_prologue(a, lds, wave, LANE()); } SEAM(0);
    if (IN(1)) REPS(1) { pg8::Gemm g{(const bf16*)(ws + WS_X1B), (const bf16*)(ws + WS_WIN), M, INC, DM}; pg8::StaticOrder S; S.init(M, INC, gridDim.x, blockIdx.x);
        pg8::EpiP E{(bf16*)(ws + WS_P), (const float*)(ws + WS_RS1), lds + pg8::STAGE_BYTES}; pg8::gemm_phase<pg8::EpiP, pg8::StaticOrder, true, true, false>(lds, g, S, E, wave); } SEAM(1);
    if (IN(2)) REPS(2) { phase_mixer(a, lds, wave, LANE()); } SEAM(2);
    if (IN(3)) { phase_mixer2(a, lds, wave, LANE()); } SEAM(3);
    if (IN(4)) { pg8::Gemm g{(const bf16*)(ws + WS_Y), (const bf16*)(ws + WS_WOUT), M, DM, DM}; pg8::StaticOrder S; S.init(M, DM, gridDim.x, blockIdx.x);
        pg8::EpiRes<true, true> E{nullptr, (bf16*)(ws + WS_X1B), (float*)(ws + WS_SS2), (const float*)(ws + WS_RSG)}; pg8::gemm_phase<pg8::EpiRes<true, true>, pg8::StaticOrder, true, true, false>(lds, g, S, E, wave); } SEAM(4);
    if (IN(5)) REPS(5) { pg8::Gemm g{(const bf16*)(ws + WS_X1B), (const bf16*)(ws + WS_WUP), M, NUP, DM}; pg8::StaticOrder S; S.init(M, NUP, gridDim.x, blockIdx.x);
        pg8::EpiUp E{(const float*)(ws + WS_SS2), a.in[I_FCW], a.in[I_FCB], (bf16*)(ws + WS_ACT), (float*)(ws + WS_HALO), lds + pg8::STAGE_BYTES}; pg8::gemm_phase<pg8::EpiUp, pg8::StaticOrder, true, true, true>(lds, g, S, E, wave); } SEAM(5);
    if (IN(6)) { phase_fixup(a, wave, LANE()); } SEAM(6);
    if (IN(7)) { pg8::Gemm g{(const bf16*)(ws + WS_ACT), (const bf16*)(ws + WS_WDN), M, DM, DFF}; pg8::StaticOrder S; S.init(M, DM, gridDim.x, blockIdx.x);
        pg8::EpiRes<true, false> E{nullptr, (bf16*)(ws + WS_X1B), (float*)(ws + WS_SS3), nullptr}; pg8::gemm_phase<pg8::EpiRes<true, false>, pg8::StaticOrder, true, true, false>(lds, g, S, E, wave); } SEAM(7);
    if (IN(8)) { phase_final(a, wave, LANE()); }
#undef IN
#undef SEAM
}

extern "C" void kernel_launch(void* const* d_in, const int* in_sizes, int n_in, void* d_out, int out_size, void* d_ws, size_t ws_size, hipStream_t stream) {
    static int grid = 0;
    if (grid == 0) {
        if (n_in != 23 || out_size != M * DM || ws_size < WS_END) { fprintf(stderr, "kernel_launch: unexpected problem (n_in %d, out %d, ws %zu)\n", n_in, out_size, ws_size); grid = -1; return; }
        int dev = 0, cus = 0, per_cu = 0;
        hipGetDevice(&dev); hipDeviceGetAttribute(&cus, hipDeviceAttributeMultiprocessorCount, dev);
        if (hipFuncSetAttribute((const void*)hymba_fwd, hipFuncAttributeMaxDynamicSharedMemorySize, LDS_BYTES) != hipSuccess) { fprintf(stderr, "kernel_launch: hipFuncSetAttribute failed\n"); grid = -1; return; }
        if (hipOccupancyMaxActiveBlocksPerMultiprocessor(&per_cu, (const void*)hymba_fwd, NTHREADS, LDS_BYTES) != hipSuccess || per_cu < 1) { fprintf(stderr, "kernel_launch: occupancy query says %d\n", per_cu); per_cu = 1; }
        (void)hipGetLastError();
        grid = cus;
    }
    if (grid < 0) return;
    Args a{};
    for (int i = 0; i < 23; ++i) a.in[i] = (const float*)d_in[i];
    a.out = (float*)d_out; a.ws = (unsigned char*)d_ws;
#if MK_N_LAUNCHES == 1
    a.ph_lo = 0; a.ph_hi = N_PHASES;
    void* args[] = {&a};
    hipError_t e = hipLaunchCooperativeKernel((const void*)hymba_fwd, dim3(grid), dim3(NTHREADS), args, LDS_BYTES, stream);
    if (e != hipSuccess) fprintf(stderr, "kernel_launch: cooperative launch failed: %s (grid %d)\n", hipGetErrorString(e), grid);
#else
#ifndef DUP_PHASE
#define DUP_PHASE -1
#endif
    for (int p = 0; p < N_PHASES; ++p) { a.ph_lo = p; a.ph_hi = p + 1; hipLaunchKernelGGL(hymba_fwd, dim3(grid), dim3(NTHREADS), LDS_BYTES, stream, a);
        if (p == DUP_PHASE) hipLaunchKernelGGL(hymba_fwd, dim3(grid), dim3(NTHREADS), LDS_BYTES, stream, a); }
#endif
}
```

```cpp
#include <hip/hip_runtime.h>
#include <hip/hip_cooperative_groups.h>
#include <cstdio>
#include <cstdint>
namespace cg = cooperative_groups;
namespace pg8 {
#define PG8_LAS __attribute__((address_space(3)))
typedef unsigned short bf16_t;
typedef short bf16x8 __attribute__((ext_vector_type(8)));
typedef float f32x4 __attribute__((ext_vector_type(4)));
typedef unsigned u32x4 __attribute__((ext_vector_type(4)));
constexpr int BM = 256, BK = 64, HALF = 128, HTB = HALF * BK * 2  , STAGE_BYTES = 8 * HTB, NXCD = 8, WGM = 4;

__host__ __device__ __forceinline__ int lds_byte(int r, int c) { const int st = (r >> 4) * 2 + (c >> 5), rr = r & 15, cc = c & 31, ob = rr * 64 + cc * 2; return st * 1024 + (ob ^ (((ob >> 9) & 1) << 5)); }
__host__ __device__ __forceinline__ void stage_rc(int b, int& R, int& C) { const int st = b / 1024, sb = b % 1024, swz = sb ^ (((sb >> 9) & 1) << 5); R = (st >> 1) * 16 + swz / 64; C = (st & 1) * 32 + (swz % 64) / 2; }
__host__ __device__ __forceinline__ int perm32(int rho) { const int n = rho >> 4, i = rho & 15; return 8 * (i >> 2) + 4 * n + (i & 3); }

struct Unit { int pm, pn; };
struct Gemm { const bf16_t* A; const bf16_t* Bt; int M, N, K; };

struct StaticOrder {
    int nM, nN, nwg, G, c;
    __host__ __device__ void init(int M, int N, int G_, int c_) { nM = M / BM; nN = N / BM; nwg = nM * nN; G = G_; c = c_; }
    __host__ __device__ bool next(int i, Unit& u) const {
        const long L = (long)i * G + c; if (L >= nwg) return false;
        int wgid = (int)L; { const int q = nwg / NXCD, r = nwg % NXCD, xcd = wgid % NXCD, off = wgid / NXCD; wgid = (xcd < r ? xcd * (q + 1) : r * (q + 1) + (xcd - r) * q) + off; }
        const int nig = WGM * nN, gid = wgid / nig, fm = gid * WGM, gsz = (nM - fm) < WGM ? (nM - fm) : WGM;
        u.pm = fm + ((wgid % nig) % gsz); u.pn = (wgid % nig) / gsz; return true;
    }
    __device__ __forceinline__ void a_ready(const Unit&) const {}
    __device__ __forceinline__ void done(const Unit&) const {}
};

typedef unsigned u32x2 __attribute__((ext_vector_type(2)));
typedef float f32x2 __attribute__((ext_vector_type(2)));
__device__ __forceinline__ unsigned cvt_pk_bf16(float lo, float hi) { unsigned r; asm volatile("v_cvt_pk_bf16_f32 %0, %1, %2" : "=v"(r) : "v"(lo), "v"(hi)); return r; }
__device__ __forceinline__ float bf_lo(unsigned w) { return __builtin_bit_cast(float, w << 16); }
__device__ __forceinline__ float bf_hi(unsigned w) { return __builtin_bit_cast(float, w & 0xffff0000u); }
__device__ __forceinline__ float gelu_tanh(float x) {
    const float t = x * (-2.302208198f - 0.102943240f * (x * x));
    return x * __builtin_amdgcn_rcpf(1.0f + __builtin_amdgcn_exp2f(t));
}
__device__ __forceinline__ f32x2 gelu_tanh2(f32x2 x) {
    const f32x2 t = x * ((x * x) * (-0.102943240f) + (-2.302208198f));
    f32x2 e; e.x = __builtin_amdgcn_exp2f(t.x); e.y = __builtin_amdgcn_exp2f(t.y);
    const f32x2 d = e + 1.0f;
    f32x2 r; r.x = __builtin_amdgcn_rcpf(d.x); r.y = __builtin_amdgcn_rcpf(d.y);
    return x * r;
}
__device__ __forceinline__ float sigmoid_f(float x) { return __builtin_amdgcn_rcpf(1.0f + __builtin_amdgcn_exp2f(-1.4426950409f * x)); }
__device__ __forceinline__ float dpp_ror1(float v) { const int x = __builtin_bit_cast(int, v); return __builtin_bit_cast(float, __builtin_amdgcn_update_dpp(x, x, 0x121, 0xf, 0xf, false)); }
__device__ __forceinline__ float dpp_ror2(float v) { const int x = __builtin_bit_cast(int, v); return __builtin_bit_cast(float, __builtin_amdgcn_update_dpp(x, x, 0x122, 0xf, 0xf, false)); }
__device__ __forceinline__ float dpp_shr1_keep(float keep, float v) { return __builtin_bit_cast(float, __builtin_amdgcn_update_dpp(__builtin_bit_cast(int, keep), __builtin_bit_cast(int, v), 0x111, 0xf, 0xf, false)); }
__device__ __forceinline__ float dpp_shr2_keep(float keep, float v) { return __builtin_bit_cast(float, __builtin_amdgcn_update_dpp(__builtin_bit_cast(int, keep), __builtin_bit_cast(int, v), 0x112, 0xf, 0xf, false)); }

struct EpiP {
    static constexpr bool PERM = true, AFTER_DRAIN = false, MIDK = false, PREF = true;
    bf16_t* O; const float* rs1; PG8_LAS unsigned char* pf;
    __device__ __forceinline__ void pre(const Unit& u, int wid, int lane) const {
        if (wid == 0) __builtin_amdgcn_global_load_lds((const unsigned*)(rs1 + u.pm * BM + 4 * lane), (PG8_LAS unsigned*)pf, 16, 0, 0);
    }
    __device__ __forceinline__ void operator()(const f32x4 (&acc)[2][2][4][2], const Unit& u, int wr, int wc, int fr, int fq) const {
        const int row0 = u.pm * BM + wr * 64 + fr, col0 = u.pn * BM + wc * 32 + 8 * fq;
        const bool act = u.pn < 12;
        float rs[2][4];
#pragma unroll
        for (int ai = 0; ai < 2; ++ai)
#pragma unroll
            for (int m = 0; m < 4; ++m) rs[ai][m] = *(const PG8_LAS float*)(pf + 4 * (wr * 64 + fr + ai * HALF + m * 16));
#pragma unroll
        for (int ai = 0; ai < 2; ++ai)
#pragma unroll
            for (int m = 0; m < 4; ++m) { bf16_t* rowp = O + (size_t)(row0 + ai * HALF + m * 16) * 4096 + col0;
#pragma unroll
                for (int bj = 0; bj < 2; ++bj) { f32x4 v0 = acc[ai][bj][m][0] * rs[ai][m], v1 = acc[ai][bj][m][1] * rs[ai][m];
                    if (act) { const f32x2 a0 = gelu_tanh2((f32x2){v0[0], v0[1]}), a1 = gelu_tanh2((f32x2){v0[2], v0[3]}), b0 = gelu_tanh2((f32x2){v1[0], v1[1]}), b1 = gelu_tanh2((f32x2){v1[2], v1[3]});
                        v0 = (f32x4){a0.x, a0.y, a1.x, a1.y}; v1 = (f32x4){b0.x, b0.y, b1.x, b1.y}; }
                    u32x4 w; w.x = cvt_pk_bf16(v0[0], v0[1]); w.y = cvt_pk_bf16(v0[2], v0[3]); w.z = cvt_pk_bf16(v1[0], v1[1]); w.w = cvt_pk_bf16(v1[2], v1[3]);
                    *(u32x4*)(rowp + bj * HALF) = w; } }
    }
};
template <bool RBF, bool MID> struct EpiRes {
    static constexpr bool PERM = true, AFTER_DRAIN = false, MIDK = MID, PREF = false;
    const float* xi; bf16_t* xb; float* ss; const float* rsg;
    __device__ __forceinline__ void mid(f32x4 (&acc)[2][2][4][2], const Unit& u, int wr, int wc, int fr, int fq) const {
        const int row0 = u.pm * BM + wr * 64 + fr;
#pragma unroll
        for (int ai = 0; ai < 2; ++ai)
#pragma unroll
            for (int m = 0; m < 4; ++m) { const float s = rsg[row0 + ai * HALF + m * 16];
#pragma unroll
                for (int bj = 0; bj < 2; ++bj)
#pragma unroll
                    for (int n = 0; n < 2; ++n) acc[ai][bj][m][n] = acc[ai][bj][m][n] * s; }
    }
    __device__ __forceinline__ void operator()(const f32x4 (&acc)[2][2][4][2], const Unit& u, int wr, int wc, int fr, int fq) const {
        const int row0 = u.pm * BM + wr * 64 + fr, col0 = u.pn * BM + wc * 32 + 8 * fq;
#pragma unroll
        for (int ai = 0; ai < 2; ++ai) {
            u32x4 rb[4][2]; f32x4 rf[4][2][2];
#pragma unroll
            for (int m = 0; m < 4; ++m)
#pragma unroll
                for (int bj = 0; bj < 2; ++bj) { const size_t o = (size_t)(row0 + ai * HALF + m * 16) * 2048 + col0 + bj * HALF;
                    if (RBF) rb[m][bj] = *(const u32x4*)(xb + o); else { rf[m][bj][0] = *(const f32x4*)(xi + o); rf[m][bj][1] = *(const f32x4*)(xi + o + 4); } }
#pragma unroll
            for (int m = 0; m < 4; ++m) { const int row = row0 + ai * HALF + m * 16; const size_t off = (size_t)row * 2048 + col0; float s = 0.f;
#pragma unroll
                for (int bj = 0; bj < 2; ++bj) { f32x4 r0, r1;
                    if (RBF) { const u32x4 rw = rb[m][bj]; r0 = (f32x4){bf_lo(rw.x), bf_hi(rw.x), bf_lo(rw.y), bf_hi(rw.y)}; r1 = (f32x4){bf_lo(rw.z), bf_hi(rw.z), bf_lo(rw.w), bf_hi(rw.w)}; } else { r0 = rf[m][bj][0]; r1 = rf[m][bj][1]; }
                    const f32x4 v0 = r0 + acc[ai][bj][m][0], v1 = r1 + acc[ai][bj][m][1];
                    s += ((v0[0] * v0[0] + v0[1] * v0[1]) + (v0[2] * v0[2] + v0[3] * v0[3])) + ((v1[0] * v1[0] + v1[1] * v1[1]) + (v1[2] * v1[2] + v1[3] * v1[3]));
                    u32x4 w; w.x = cvt_pk_bf16(v0[0], v0[1]); w.y = cvt_pk_bf16(v0[2], v0[3]); w.z = cvt_pk_bf16(v1[0], v1[1]); w.w = cvt_pk_bf16(v1[2], v1[3]); *(u32x4*)(xb + off + bj * HALF) = w; }
                s += __shfl_xor(s, 16); s += __shfl_xor(s, 32);
                if (fq == 0) unsafeAtomicAdd(ss + row, s); }
            asm volatile("" ::: "memory");
        }
    }
};
struct EpiUp {
    static constexpr bool PERM = true, AFTER_DRAIN = false, MIDK = false, PREF = true;
    const float* ss2; const float* cw; const float* cb; bf16_t* act; float* halo; PG8_LAS unsigned char* pf;
    __device__ __forceinline__ void pre(const Unit& u, int wid, int lane) const {
        if (wid == 0) __builtin_amdgcn_global_load_lds((const unsigned*)(ss2 + u.pm * BM + 4 * lane), (PG8_LAS unsigned*)pf, 16, 0, 0);
        else if (wid <= 4) { const int p = 2 * (wid - 1) + (lane >> 5), c = u.pn * 128 + 4 * (lane & 31);
            const float* base = (p & 3) == 3 ? cb : cw + 12288 * (p & 3);
            __builtin_amdgcn_global_load_lds((const unsigned*)(base + (p >> 2) * 6144 + c), (PG8_LAS unsigned*)(pf + 1024 + 1024 * (wid - 1)), 16, 0, 0); }
    }
    __device__ __forceinline__ void operator()(const f32x4 (&acc)[2][2][4][2], const Unit& u, int wr, int wc, int fr, int fq) const {
        const int rbase = u.pm * BM + wr * 128 + 4 * fr, grp = u.pm * 2 + wr;
        const int ca = u.pn * 128 + wc * 32 + 8 * fq;
        const bool l15 = fr == 15;
        f32x4 pG[2][2], pV[2][2];
#pragma unroll
        for (int n = 0; n < 2; ++n)
#pragma unroll
            for (int k = 0; k < 2; ++k) { pG[n][k] = (f32x4){0.f, 0.f, 0.f, 0.f}; pV[n][k] = pG[n][k]; }
#pragma unroll
        for (int ai = 0; ai < 2; ++ai) {
            const f32x4 ssv = *(const PG8_LAS f32x4*)(pf + 4 * (wr * 128 + 64 * ai + 4 * fr));
            float rs[4];
#pragma unroll
            for (int m = 0; m < 4; ++m) rs[m] = __builtin_amdgcn_rsqf(ssv[m] * (1.0f / 2048.0f) + 1e-6f);
            u32x2 wlo[4];
#pragma unroll
            for (int n = 0; n < 2; ++n) {
                const int cl = wc * 32 + 8 * fq + 4 * n;
                f32x4 pw[8];
#pragma unroll
                for (int p = 0; p < 8; ++p) pw[p] = *(const PG8_LAS f32x4*)(pf + 1024 + 512 * p + 4 * cl);
                f32x4 G[4], V[4];
#pragma unroll
                for (int m = 0; m < 4; ++m) { G[m] = acc[ai][0][m][n] * rs[m]; V[m] = acc[ai][1][m][n] * rs[m]; }
                f32x4 G3s, G2s, V3s, V2s;
#pragma unroll
                for (int j = 0; j < 4; ++j) { G3s[j] = dpp_ror1(l15 ? pG[n][1][j] : G[3][j]); G2s[j] = dpp_ror1(l15 ? pG[n][0][j] : G[2][j]);
                    V3s[j] = dpp_ror1(l15 ? pV[n][1][j] : V[3][j]); V2s[j] = dpp_ror1(l15 ? pV[n][0][j] : V[2][j]); }
#pragma unroll
                for (int m = 0; m < 4; ++m) {
                    const f32x4 g1 = m >= 1 ? G[m >= 1 ? m - 1 : 0] : G3s, g2 = m >= 2 ? G[m >= 2 ? m - 2 : 0] : (m == 1 ? G3s : G2s);
                    const f32x4 v1 = m >= 1 ? V[m >= 1 ? m - 1 : 0] : V3s, v2 = m >= 2 ? V[m >= 2 ? m - 2 : 0] : (m == 1 ? V3s : V2s);
                    const f32x4 cgv = pw[3] + pw[2] * G[m] + pw[1] * g1 + pw[0] * g2, cvv = pw[7] + pw[6] * V[m] + pw[5] * v1 + pw[4] * v2;
                    const f32x2 o01 = gelu_tanh2((f32x2){cgv[0], cgv[1]}) * (f32x2){cvv[0], cvv[1]}, o23 = gelu_tanh2((f32x2){cgv[2], cgv[3]}) * (f32x2){cvv[2], cvv[3]};
                    const unsigned lo = cvt_pk_bf16(o01.x, o01.y), hi = cvt_pk_bf16(o23.x, o23.y);
                    if (n == 0) { wlo[m].x = lo; wlo[m].y = hi; }
                    else if (ai == 1 || m >= 2 || fr != 0) { u32x4 w; w.x = wlo[m].x; w.y = wlo[m].y; w.z = lo; w.w = hi;
                        *(u32x4*)(act + (size_t)(rbase + 64 * ai + m) * 6144 + ca) = w; }
                    if ((ai == 0 && m < 2) || (ai == 1 && m >= 2)) {
                        if (fr == (ai == 0 ? 0 : 15)) { float* hp = halo + ((size_t)(grp * 4 + m) * 2) * 6144 + ca + 4 * n; *(f32x4*)hp = G[m]; *(f32x4*)(hp + 6144) = V[m]; } }
                }
                pG[n][0] = G[2]; pG[n][1] = G[3]; pV[n][0] = V[2]; pV[n][1] = V[3];
            }
        }
    }
};

template <class Epi, class Sched, bool ALIGN_EPI = false, bool SP2 = false, bool APERM = false>
__device__ __forceinline__ void gemm_phase(PG8_LAS unsigned char* lds, const Gemm g, const Sched& S, const Epi& E, const int wid) {
    const int lane = (int)__builtin_amdgcn_mbcnt_hi(~0u, __builtin_amdgcn_mbcnt_lo(~0u, 0u)), tid = wid * 64 + lane, wr = wid >> 2, wc = wid & 3, fr = lane & 15, fq = lane >> 4;
    const int K = g.K, nt = K / BK;
    unsigned voffA[2], voffB[2];
#pragma unroll
    for (int i = 0; i < 2; ++i) { int R, C; stage_rc(tid * 16 + i * 8192, R, C); const int Rb = Epi::PERM ? ((R & ~31) + perm32(R & 31)) : R;
        const int Ra = APERM ? (128 * (R >> 6) + 4 * (R & 15) + ((R >> 4) & 3)) : R;     voffA[i] = (unsigned)(Ra * K + C) * 2u; voffB[i] = (unsigned)(Rb * K + C) * 2u; }
    const size_t kstep = (size_t)(BK * 2);
    const size_t hstep = (size_t)HALF * K * 2;
    const size_t hstepA = APERM ? (size_t)64 * K * 2 : hstep;
    const size_t tstep = 2 * hstep;
    const unsigned ldsw = (unsigned)wid * 1024u;
    const int aoff = lds_byte(wr * 64 + fr, fq * 8), boff = lds_byte(wc * 32 + fr, fq * 8);
#define PG8_SA(b, h) (((b) * 2 + (h)) * HTB)
#define PG8_SB(b, h) ((4 + (b) * 2 + (h)) * HTB)
#define PG8_STAGE(bufoff, gbase, voff) do { _Pragma("unroll") for (int _i = 0; _i < 2; ++_i) \
        __builtin_amdgcn_global_load_lds((const unsigned*)((const char*)(gbase) + (voff)[_i]), (PG8_LAS unsigned*)(lds + (bufoff) + ldsw + _i * 8192), 16, 0, 0); } while (0)
#define PG8_LDA(dst, b, h) do { _Pragma("unroll") for (int m = 0; m < 4; ++m) _Pragma("unroll") for (int k = 0; k < 2; ++k) dst[m][k] = *(const PG8_LAS bf16x8*)(lds + PG8_SA(b, h) + aoff + m * 2048 + k * 1024); } while (0)
#define PG8_LDB(dst, b, h) do { _Pragma("unroll") for (int n = 0; n < 2; ++n) _Pragma("unroll") for (int k = 0; k < 2; ++k) dst[n][k] = *(const PG8_LAS bf16x8*)(lds + PG8_SB(b, h) + boff + n * 2048 + k * 1024); } while (0)
#define PG8_MMA(ai, bj, At, Bt) do { __builtin_amdgcn_s_setprio(1); _Pragma("unroll") for (int m = 0; m < 4; ++m) _Pragma("unroll") for (int n = 0; n < 2; ++n) _Pragma("unroll") for (int k = 0; k < 2; ++k) \
        acc[ai][bj][m][n] = __builtin_amdgcn_mfma_f32_16x16x32_bf16(Bt[n][k], At[m][k], acc[ai][bj][m][n], 0, 0, 0); __builtin_amdgcn_s_setprio(0); } while (0)
#define PG8_WAIT_V(n) asm volatile("s_waitcnt vmcnt(" #n ")" ::: "memory")
#define PG8_WAIT_L(n) asm volatile("s_waitcnt lgkmcnt(" #n ")" ::: "memory")
#define PG8_BAR __builtin_amdgcn_s_barrier()
#define PG8_SCHED __builtin_amdgcn_sched_barrier(0)
    Unit cur, nxt; int ui = 0;
    if (!S.next(0, cur)) return;
    f32x4 acc[2][2][4][2];
#pragma unroll
    for (int a = 0; a < 2; ++a)
#pragma unroll
        for (int b = 0; b < 2; ++b)
#pragma unroll
            for (int m = 0; m < 4; ++m)
#pragma unroll
                for (int n = 0; n < 2; ++n) acc[a][b][m][n] = (f32x4){0.f, 0.f, 0.f, 0.f};
    bf16x8 At[4][2], B0[2][2], B1[2][2];
    const char* cA = (const char*)g.A + (size_t)cur.pm * tstep; const char* cB = (const char*)g.Bt + (size_t)cur.pn * tstep;
    S.a_ready(cur);
    if constexpr (SP2) {
        PG8_STAGE(PG8_SB(0, 0), cB, voffB); PG8_STAGE(PG8_SB(0, 1), cB + hstep, voffB); PG8_STAGE(PG8_SA(0, 0), cA, voffA); PG8_STAGE(PG8_SA(0, 1), cA + hstepA, voffA);
        if (wr == 1) PG8_BAR;
        PG8_WAIT_V(2); PG8_BAR;
        PG8_STAGE(PG8_SB(1, 0), cB + kstep, voffB); PG8_STAGE(PG8_SA(1, 0), cA + kstep, voffA); PG8_STAGE(PG8_SB(1, 1), cB + hstep + kstep, voffB);
        PG8_WAIT_V(6); PG8_BAR;
    } else {
        PG8_STAGE(PG8_SB(0, 0), cB, voffB); PG8_STAGE(PG8_SA(0, 0), cA, voffA); PG8_STAGE(PG8_SB(0, 1), cB + hstep, voffB); PG8_STAGE(PG8_SA(0, 1), cA + hstepA, voffA);
        if (wr == 1) PG8_BAR;
        PG8_WAIT_V(4); PG8_BAR;
        PG8_STAGE(PG8_SB(1, 0), cB + kstep, voffB); PG8_STAGE(PG8_SA(1, 0), cA + kstep, voffA); PG8_STAGE(PG8_SB(1, 1), cB + hstep + kstep, voffB);
        PG8_WAIT_V(6); PG8_BAR;
    }
    for (;;) {
        const bool has_next = S.next(ui + 1, nxt);
        const char* nA = has_next ? (const char*)g.A + (size_t)nxt.pm * tstep : cA; const char* nB = has_next ? (const char*)g.Bt + (size_t)nxt.pn * tstep : cB;
        for (int t = 0; t < nt; t += 2) {
            const bool last = (t == nt - 2);
            const char* a1 = cA + (size_t)(t + 1) * kstep;
            const char* a2 = last ? nA : cA + (size_t)(t + 2) * kstep; const char* b2 = last ? nB : cB + (size_t)(t + 2) * kstep;
            const char* a3 = a2 + kstep; const char* b3 = b2 + kstep;
            if (last && has_next) S.a_ready(nxt);
            if constexpr (Epi::PREF) { if (last) E.pre(cur, wid, lane); }
            if constexpr (Epi::MIDK) { if (t == nt / 2) E.mid(acc, cur, wr, wc, fr, fq); }
            if constexpr (SP2) {
            PG8_LDB(B0, 0, 0); PG8_LDB(B1, 0, 1); PG8_SCHED; PG8_LDA(At, 0, 0); PG8_STAGE(PG8_SA(1, 1), a1 + hstepA, voffA);
            PG8_WAIT_V(8); PG8_WAIT_L(0); PG8_BAR; PG8_MMA(0, 0, At, B0); PG8_MMA(0, 1, At, B1); PG8_BAR; PG8_SCHED;
            PG8_LDA(At, 0, 1); PG8_STAGE(PG8_SB(0, 0), b2, voffB); PG8_STAGE(PG8_SB(0, 1), b2 + hstep, voffB); PG8_STAGE(PG8_SA(0, 0), a2, voffA);
            PG8_WAIT_V(8); PG8_WAIT_L(0); PG8_BAR; PG8_MMA(1, 0, At, B0); PG8_MMA(1, 1, At, B1); PG8_BAR; PG8_SCHED;
            PG8_LDB(B0, 1, 0); PG8_LDB(B1, 1, 1); PG8_SCHED; PG8_LDA(At, 1, 0); PG8_STAGE(PG8_SA(0, 1), a2 + hstepA, voffA);
            PG8_WAIT_V(8); PG8_WAIT_L(0); PG8_BAR; PG8_MMA(0, 0, At, B0); PG8_MMA(0, 1, At, B1); PG8_BAR; PG8_SCHED;
            PG8_LDA(At, 1, 1); PG8_STAGE(PG8_SB(1, 0), b3, voffB); PG8_STAGE(PG8_SB(1, 1), b3 + hstep, voffB); PG8_STAGE(PG8_SA(1, 0), a3, voffA);
            PG8_WAIT_V(8); PG8_WAIT_L(0); PG8_BAR; PG8_MMA(1, 0, At, B0); PG8_MMA(1, 1, At, B1); PG8_BAR; PG8_SCHED;
            } else {
            PG8_LDB(B0, 0, 0); PG8_SCHED; PG8_LDA(At, 0, 0); PG8_STAGE(PG8_SA(1, 1), a1 + hstepA, voffA);
            PG8_WAIT_L(8); PG8_BAR; PG8_WAIT_L(0); PG8_MMA(0, 0, At, B0); PG8_BAR; PG8_SCHED;
            PG8_LDB(B1, 0, 1); PG8_STAGE(PG8_SB(0, 0), b2, voffB);
            PG8_BAR; PG8_WAIT_L(0); PG8_MMA(0, 1, At, B1); PG8_BAR;
            PG8_LDA(At, 0, 1); PG8_STAGE(PG8_SA(0, 0), a2, voffA);
            PG8_BAR; PG8_WAIT_L(0); PG8_MMA(1, 0, At, B0); PG8_BAR; PG8_SCHED;
            PG8_STAGE(PG8_SB(0, 1), b2 + hstep, voffB);
            PG8_WAIT_V(6); PG8_BAR; PG8_MMA(1, 1, At, B1); PG8_BAR;
            PG8_LDB(B0, 1, 0); PG8_SCHED; PG8_LDA(At, 1, 0); PG8_STAGE(PG8_SA(0, 1), a2 + hstepA, voffA);
            PG8_WAIT_L(8); PG8_BAR; PG8_WAIT_L(0); PG8_MMA(0, 0, At, B0); PG8_BAR; PG8_SCHED;
            PG8_LDB(B1, 1, 1); PG8_STAGE(PG8_SB(1, 0), b3, voffB);
            PG8_BAR; PG8_WAIT_L(0); PG8_MMA(0, 1, At, B1); PG8_BAR;
            PG8_LDA(At, 1, 1); PG8_STAGE(PG8_SA(1, 0), a3, voffA);
            PG8_BAR; PG8_WAIT_L(0); PG8_MMA(1, 0, At, B0); PG8_BAR; PG8_SCHED;
            PG8_STAGE(PG8_SB(1, 1), b3 + hstep, voffB);
            PG8_WAIT_V(6); PG8_BAR; PG8_MMA(1, 1, At, B1); PG8_BAR;
            }
        }
        if constexpr (ALIGN_EPI) { if (wr == 0) PG8_BAR; }
        if constexpr (!Epi::AFTER_DRAIN) { E(acc, cur, wr, wc, fr, fq); S.done(cur); }
        if (!has_next) break;
#pragma unroll
        for (int a = 0; a < 2; ++a)
#pragma unroll
            for (int b = 0; b < 2; ++b)
#pragma unroll
                for (int m = 0; m < 4; ++m)
#pragma unroll
                    for (int n = 0; n < 2; ++n) acc[a][b][m][n] = (f32x4){0.f, 0.f, 0.f, 0.f};
        cur = nxt; cA = nA; cB = nB; ++ui;
        if constexpr (ALIGN_EPI) { if (wr == 1) PG8_BAR; }
    }
    PG8_WAIT_V(0);
    if constexpr (!ALIGN_EPI) { if (wr == 0) PG8_BAR; }
    PG8_BAR;
    if constexpr (Epi::AFTER_DRAIN) { E.fused(acc, cur, wr, wc, fr, fq, lds, wid, lane); S.done(cur); }
#undef PG8_SA
#undef PG8_SB
#undef PG8_STAGE
#undef PG8_LDA
#undef PG8_LDB
#undef PG8_MMA
#undef PG8_WAIT_V
#undef PG8_WAIT_L
#undef PG8_BAR
#undef PG8_SCHED
}
}

#define LAS __attribute__((address_space(3)))
typedef unsigned short bf16;
typedef float f32x4 __attribute__((ext_vector_type(4)));
typedef float f32x2 __attribute__((ext_vector_type(2)));
typedef unsigned u32x4 __attribute__((ext_vector_type(4)));
typedef unsigned u32x2 __attribute__((ext_vector_type(2)));
typedef short bf16x8 __attribute__((ext_vector_type(8)));
using pg8::cvt_pk_bf16; using pg8::bf_lo; using pg8::bf_hi; using pg8::gelu_tanh; using pg8::sigmoid_f;

constexpr int NWAVES = 8, NTHREADS = 512;
constexpr int DM = 2048, NB = 4, SEQ = 8192, M = NB * SEQ;
constexpr int INC = 4096, DFF = 6144, NUP = 12288, NCHUNK = SEQ / 128, NTILE = M / 128;
constexpr float RMS_EPS = 1e-6f, LN_EPS = 1e-5f;
constexpr int LDS_BYTES = 155648;
constexpr int WSTRIDE = 17408;
constexpr int STATS_OFF = 8 * WSTRIDE;
constexpr int CARRYL_OFF = STATS_OFF + 1024;

constexpr size_t MiB = 1u << 20;
constexpr size_t WS_SS2 = 0, WS_RS1 = 512 * 1024, WS_RSG = 768 * 1024, WS_SS3 = 1 * MiB, WS_SSG = 2 * MiB  , WS_CARRY = 4 * MiB  ;
constexpr size_t WS_WM = 6 * MiB, WS_WAT = 6 * MiB + 256 * 1024, WS_WXT = 6 * MiB + 512 * 1024;
constexpr size_t WS_WIN = 7 * MiB, WS_WOUT = 23 * MiB, WS_WUP = 31 * MiB, WS_WDN = 79 * MiB;
constexpr size_t WS_X1B = 104 * MiB;
constexpr size_t WS_H1 = 256 * MiB, WS_Y = 256 * MiB, WS_P = 384 * MiB, WS_SC = 640 * MiB, WS_ACT = 256 * MiB, WS_HALO = 768 * MiB, WS_END = 816 * MiB;

struct Args { const float* in[23]; float* out; unsigned char* ws; int ph_lo, ph_hi; };
enum { I_X = 0, I_N1G, I_WIN, I_GVG, I_GVB, I_GWS, I_GBS, I_LCW, I_LCB, I_LWA, I_LBA, I_LWX, I_LBX, I_LAM, I_GOG, I_LOG, I_WOUT, I_N2G, I_WUP, I_FCW, I_FCB, I_WDN, I_FG };

__device__ __forceinline__ float wave_sum(float v) {
#pragma unroll
    for (int o = 1; o < 64; o <<= 1) v += __shfl_xor(v, o);
    return v;
}
#define LDS_WAIT() asm volatile("s_waitcnt lgkmcnt(0)" ::: "memory")
#define WAVE_SYNC() do { asm volatile("s_waitcnt lgkmcnt(0)" ::: "memory"); __builtin_amdgcn_wave_barrier(); } while (0)

__device__ __forceinline__ void transpose_item(const float* W, int K, int N, bf16* WT, int drow0, LAS float* scr  , int k0, int n0, int lane, const float* ks0, const float* ks1, int ksplit) {
    const int r4 = lane >> 4, c4 = (lane & 15) * 4;
#pragma unroll 8
    for (int i = 0; i < 16; ++i) { const int kk = 4 * i + r4, k = k0 + kk; f32x4 v = *(const f32x4*)(W + (size_t)k * N + n0 + c4);
        if (ks0) v = v * (k < ksplit ? ks0[k] : ks1[k - ksplit]);
        LAS float* d = scr + kk * 65 + c4; d[0] = v[0]; d[1] = v[1]; d[2] = v[2]; d[3] = v[3]; }
    LDS_WAIT(); __builtin_amdgcn_wave_barrier();
    const int c = lane & 7;
#pragma unroll
    for (int i = 0; i < 8; ++i) { const int n = (lane >> 3) + 8 * i; const LAS float* s = scr + (8 * c) * 65 + n;
        u32x4 o; o.x = cvt_pk_bf16(s[0 * 65], s[1 * 65]); o.y = cvt_pk_bf16(s[2 * 65], s[3 * 65]); o.z = cvt_pk_bf16(s[4 * 65], s[5 * 65]); o.w = cvt_pk_bf16(s[6 * 65], s[7 * 65]);
        *(u32x4*)(WT + (size_t)(drow0 + n) * K + k0 + 8 * c) = o; }
    LDS_WAIT(); __builtin_amdgcn_wave_barrier();
}

__device__ __forceinline__ void phase_prologue(const Args& a, LAS unsigned char* lds, int wave, int lane) {
    unsigned char* ws = a.ws;
    LAS float* scr = (LAS float*)(lds + wave * WSTRIDE);
    const int gw = blockIdx.x * NWAVES + wave, NGW = gridDim.x * NWAVES;
    const int gt = blockIdx.x * NTHREADS + wave * 64 + lane, NGT = gridDim.x * NTHREADS;
    { float* s2 = (float*)(ws + WS_SS2); float* s3 = (float*)(ws + WS_SS3); for (int i = gt; i < M; i += NGT) { s2[i] = 0.f; s3[i] = 0.f; } }
    { bf16* wm = (bf16*)(ws + WS_WM); bf16* wat = (bf16*)(ws + WS_WAT); bf16* wxt = (bf16*)(ws + WS_WXT);
      const float* gws = a.in[I_GWS]; const float* wa = a.in[I_LWA]; const float* wx = a.in[I_LWX];
      for (int i = gt; i < 8 * 128 * 128 / 2; i += NGT) { const int e = 2 * i, s = e & 127, t = (e >> 7) & 127;
          const float v0 = s <= t ? gws[e] : 0.f, v1 = (s + 1) <= t ? gws[e + 1] : 0.f; ((unsigned*)wm)[i] = cvt_pk_bf16(v0, v1);
          const int h = e >> 14, jj = (e >> 7) & 127, ii = e & 127;
          const size_t src = (size_t)h * 16384 + (size_t)ii * 128 + jj;
          ((unsigned*)wat)[i] = cvt_pk_bf16(wa[src], wa[src + 128]); ((unsigned*)wxt)[i] = cvt_pk_bf16(wx[src], wx[src + 128]); } }
    constexpr int IT_IN = (DM / 64) * (INC / 64), IT_OUT = (DM / 64) * (DM / 64), IT_UP = (DM / 64) * (NUP / 64), IT_DN = (DFF / 64) * (DM / 64);
    constexpr int NITEMS = IT_IN + IT_OUT + IT_UP + IT_DN;
    for (int it = gw; it < NITEMS; it += NGW) {
        int r = it;
        if (r < IT_IN) { const int nblk = INC / 64, kb = r / nblk, nb = r % nblk; transpose_item(a.in[I_WIN], DM, INC, (bf16*)(ws + WS_WIN), 64 * nb, scr, 64 * kb, 64 * nb, lane, a.in[I_N1G], a.in[I_N1G], DM); continue; } r -= IT_IN;
        if (r < IT_OUT) { const int nblk = DM / 64, kb = r / nblk, nb = r % nblk; transpose_item(a.in[I_WOUT], DM, DM, (bf16*)(ws + WS_WOUT), 64 * nb, scr, 64 * kb, 64 * nb, lane, a.in[I_GOG], a.in[I_LOG], 1024); continue; } r -= IT_OUT;
        if (r < IT_UP) { const int nblk = NUP / 64, kb = r / nblk, nb = r % nblk; const int n0 = 64 * nb, bj = n0 / DFF, aa = n0 % DFF, drow = 256 * (aa >> 7) + 128 * bj + (aa & 127);
            transpose_item(a.in[I_WUP], DM, NUP, (bf16*)(ws + WS_WUP), drow, scr, 64 * kb, n0, lane, a.in[I_N2G], a.in[I_N2G], DM); continue; } r -= IT_UP;
        { const int nblk = DM / 64, kb = r / nblk, nb = r % nblk; transpose_item(a.in[I_WDN], DFF, DM, (bf16*)(ws + WS_WDN), 64 * nb, scr, 64 * kb, 64 * nb, lane, nullptr, nullptr, 0); }
    }
    { bf16* XB = (bf16*)(ws + WS_X1B); float* RS1 = (float*)(ws + WS_RS1);
      for (int m = gw; m < M; m += NGW) { const f32x4* xr = (const f32x4*)(a.in[I_X] + (size_t)m * DM) + lane; f32x4 v[8]; float s = 0.f;
#pragma unroll
          for (int j = 0; j < 8; ++j) { v[j] = xr[64 * j]; s += (v[j][0] * v[j][0] + v[j][1] * v[j][1]) + (v[j][2] * v[j][2] + v[j][3] * v[j][3]); }
          u32x2* o = (u32x2*)(XB + (size_t)m * DM) + lane;
#pragma unroll
          for (int j = 0; j < 8; ++j) { u32x2 w; w.x = cvt_pk_bf16(v[j][0], v[j][1]); w.y = cvt_pk_bf16(v[j][2], v[j][3]); o[64 * j] = w; }
          const float rs = __builtin_amdgcn_rsqf(wave_sum(s) * (1.0f / DM) + RMS_EPS);
          if (lane == 0) RS1[m] = rs; } }
}

__device__ __forceinline__ void lru_nt_scan(const f32x4 (&ar)[4], const f32x4 (&ax)[4], float bav, float bxv, float lam, LAS bf16* WL, LAS f32x2* carryL,
                                            unsigned* SCrow  , int nt, int fr, int fq) {
    const int jl = 16 * nt + fr;
    const f32x2 c0v = carryL[jl]; float cPn = c0v.x, cHn = c0v.y;
    const float spv = (fmaxf(-lam, 0.f) + __logf(1.0f + __expf(-fabsf(lam)))) * (8.0f * 1.4426950409f);
#pragma unroll
    for (int m = 0; m < 4; ++m) {
        float A[4], H[4];
#pragma unroll
        for (int r = 0; r < 4; ++r) { const float rr = sigmoid_f(ar[m][r] + bav), ii = sigmoid_f(ax[m][r] + bxv); const float av = __builtin_amdgcn_exp2f(-rr * spv);
            const float mult = __builtin_amdgcn_sqrtf(fmaxf(1.0f - av * av, 0.f)); const float xv = __builtin_bit_cast(float, (unsigned)WL[(16 * m + 4 * fq + r) * 136 + jl] << 16);
            const float bv = mult * ii * xv;
            if (r == 0) { A[0] = av; H[0] = bv; } else { A[r] = av * A[r - 1]; H[r] = av * H[r - 1] + bv; } }
        float xA = A[3], xH = H[3];
        float yA = __shfl_up(xA, 16), yH = __shfl_up(xH, 16); if (fq >= 1) { xH = xA * yH + xH; xA = xA * yA; }
        yA = __shfl_up(xA, 32); yH = __shfl_up(xH, 32); if (fq >= 2) { xH = xA * yH + xH; xA = xA * yA; }
        float eA = __shfl_up(xA, 16), eH = __shfl_up(xH, 16); if (fq == 0) { eA = 1.f; eH = 0.f; }
        const float pA = cPn * eA, pH = eA * cHn + eH;
#pragma unroll
        for (int r = 0; r < 4; ++r) { const float Pr = pA * A[r], hr = A[r] * pH + H[r]; SCrow[(size_t)(16 * m + 4 * fq + r) * 1024 + jl] = cvt_pk_bf16(hr, Pr); }
        const float tA = __shfl(xA, fr + 48), tH = __shfl(xH, fr + 48);
        cHn = tA * cHn + tH; cPn = cPn * tA;
    }
    if (fq == 0) carryL[jl] = (f32x2){cPn, cHn};
}

__device__ __forceinline__ void phase_mixer(const Args& a, LAS unsigned char* lds, int wave, int lane) {
    unsigned char* ws = a.ws;
    const bf16* P = (const bf16*)(ws + WS_P); bf16* Y = (bf16*)(ws + WS_Y); unsigned* SC = (unsigned*)(ws + WS_SC);
    float* SSG = (float*)(ws + WS_SSG); float* CARRY = (float*)(ws + WS_CARRY);
    const bf16* WMK = (const bf16*)(ws + WS_WM); const bf16* WAT = (const bf16*)(ws + WS_WAT); const bf16* WXT = (const bf16*)(ws + WS_WXT);
    const int fr = lane & 15, fq = lane >> 4, h = wave;
    LAS f32x2* stats = (LAS f32x2*)(lds + STATS_OFF);
    LAS bf16* WL = (LAS bf16*)(lds + wave * WSTRIDE);
    for (int tile = blockIdx.x; tile < NTILE; tile += gridDim.x) {
        const int ch = tile & (NCHUNK - 1); const size_t row0 = (size_t)tile * 128;
#pragma unroll 1
        for (int bt = 0; bt < 2; ++bt) {
            u32x4 r0[8], r1[8];
#pragma unroll
            for (int i = 0; i < 8; ++i) { const bf16* vr = P + (row0 + wave * 16 + bt * 8 + i) * INC + 1024; r0[i] = *(const u32x4*)(vr + lane * 8); r1[i] = *(const u32x4*)(vr + 512 + lane * 8); }
#pragma unroll
            for (int i = 0; i < 8; ++i) { float s = 0.f, q = 0.f;
#pragma unroll
                for (int k = 0; k < 4; ++k) { const float f0 = bf_lo(r0[i][k]), f1 = bf_hi(r0[i][k]), f2 = bf_lo(r1[i][k]), f3 = bf_hi(r1[i][k]); s += (f0 + f1) + (f2 + f3); q += (f0 * f0 + f1 * f1) + (f2 * f2 + f3 * f3); }
                s = wave_sum(s); q = wave_sum(q); const float mean = s * (1.0f / 1024.0f), var = q * (1.0f / 1024.0f) - mean * mean;
                if (lane == 0) stats[wave * 16 + bt * 8 + i] = (f32x2){mean, __builtin_amdgcn_rsqf(var + LN_EPS)}; }
        }
        __syncthreads();
#pragma unroll 1
        for (int hh = 0; hh < 2; ++hh) {
            const int cbase = 128 * h + 64 * hh;
            u32x2 U[4][4]; float bst[4];
#pragma unroll
            for (int m = 0; m < 4; ++m) { bst[m] = a.in[I_GBS][h * 128 + 16 * m + fr];
#pragma unroll
                for (int n = 0; n < 4; ++n) U[m][n] = *(const u32x2*)(P + (row0 + 16 * m + fr) * INC + cbase + 16 * n + 4 * fq); }
            { const int cgp = lane & 7, tg = lane >> 3, c0 = 8 * cgp;
              float gv[8], bv[8];
#pragma unroll
              for (int j = 0; j < 8; ++j) { gv[j] = a.in[I_GVG][cbase + c0 + j]; bv[j] = a.in[I_GVB][cbase + c0 + j]; }
#pragma unroll 1
              for (int task = 0; task < 2; ++task) { const int s0 = 8 * (tg + 8 * task);
                  float vals[8][8];
#pragma unroll
                  for (int s = 0; s < 8; ++s) { const u32x4 raw = *(const u32x4*)(P + (row0 + s0 + s) * INC + 1024 + cbase + c0); const f32x2 st = stats[s0 + s];
#pragma unroll
                      for (int k = 0; k < 4; ++k) { vals[s][2 * k] = (bf_lo(raw[k]) - st.x) * st.y * gv[2 * k] + bv[2 * k]; vals[s][2 * k + 1] = (bf_hi(raw[k]) - st.x) * st.y * gv[2 * k + 1] + bv[2 * k + 1]; } }
#pragma unroll
                  for (int j = 0; j < 8; ++j) { u32x4 w; w.x = cvt_pk_bf16(vals[0][j], vals[1][j]); w.y = cvt_pk_bf16(vals[2][j], vals[3][j]); w.z = cvt_pk_bf16(vals[4][j], vals[5][j]); w.w = cvt_pk_bf16(vals[6][j], vals[7][j]);
                      *(LAS u32x4*)(WL + (c0 + j) * 136 + s0) = w; } } }
            WAVE_SYNC();
            bf16x8 Af[2][4];
            Af[0][0] = *(const bf16x8*)(WMK + ((size_t)h * 128 + fr) * 128 + 8 * fq);
#pragma unroll 1
            for (int mh = 0; mh < 2; ++mh) {
                if (mh == 1) {
#pragma unroll
                    for (int m = 0; m < 4; ++m) { bst[m] = a.in[I_GBS][h * 128 + 64 + 16 * m + fr];
#pragma unroll
                        for (int n = 0; n < 4; ++n) U[m][n] = *(const u32x2*)(P + (row0 + 64 + 16 * m + fr) * INC + cbase + 16 * n + 4 * fq); } }
#pragma unroll
                for (int mi = 0; mi < 4; ++mi) {
                    const int m = 4 * mh + mi, kcur = m >> 1, knext = (m + 1) >> 1;
                    if (m < 7) {
#pragma unroll
                        for (int ks = 0; ks < 4; ++ks) if (ks <= knext) Af[(mi + 1) & 1][ks] = *(const bf16x8*)(WMK + ((size_t)h * 128 + 16 * (m + 1) + fr) * 128 + 32 * ks + 8 * fq); }
                    f32x4 acc[4];
#pragma unroll
                    for (int n = 0; n < 4; ++n) acc[n] = (f32x4){0.f, 0.f, 0.f, 0.f};
#pragma unroll
                    for (int ks = 0; ks < 4; ++ks) if (ks <= kcur) {
#pragma unroll
                        for (int n = 0; n < 4; ++n) { const bf16x8 Bf = *(const LAS bf16x8*)(WL + (16 * n + fr) * 136 + 32 * ks + 8 * fq); acc[n] = __builtin_amdgcn_mfma_f32_16x16x32_bf16(Bf, Af[mi & 1][ks], acc[n], 0, 0, 0); } }
                    const int t = 16 * m + fr; float sq = 0.f;
#pragma unroll
                    for (int n = 0; n < 4; ++n) { const int cc = cbase + 16 * n + 4 * fq; const u32x2 uu = U[mi][n];
                        const float y0 = bf_lo(uu.x) * (acc[n][0] + bst[mi]), y1 = bf_hi(uu.x) * (acc[n][1] + bst[mi]), y2 = bf_lo(uu.y) * (acc[n][2] + bst[mi]), y3 = bf_hi(uu.y) * (acc[n][3] + bst[mi]);
                        sq += (y0 * y0 + y1 * y1) + (y2 * y2 + y3 * y3); u32x2 w; w.x = cvt_pk_bf16(y0, y1); w.y = cvt_pk_bf16(y2, y3); *(u32x2*)(Y + (row0 + t) * DM + cc) = w; }
                    sq += __shfl_xor(sq, 16); sq += __shfl_xor(sq, 32); if (fq == 0) SSG[(row0 + t) * 16 + 2 * h + hh] = sq;
                    asm volatile("" ::: "memory");
                }
            }
            WAVE_SYNC();
        }
        LAS f32x2* carryL = (LAS f32x2*)(lds + CARRYL_OFF + wave * 1024);
        carryL[lane] = (f32x2){1.f, 0.f}; carryL[64 + lane] = (f32x2){1.f, 0.f};
#pragma unroll 1
        for (int hf = 0; hf < 2; ++hf) {
            const int t0 = 64 * hf;
            { const int cgp = lane & 15, tg = lane >> 4, c0 = 8 * cgp, jc = 128 * h + c0, ts = t0 + 16 * tg;
              const bf16* xp = P + (row0 + ts) * INC + 3072 + jc;
              const bool hasprev = (ch * 128 + ts) > 0;
              u32x4 rows[19];
#pragma unroll
              for (int tt = 0; tt < 16; ++tt) rows[3 + tt] = *(const u32x4*)(xp + (size_t)tt * INC);
              rows[0] = (u32x4){0u, 0u, 0u, 0u}; rows[1] = rows[0]; rows[2] = rows[0];
              if (hasprev) { rows[0] = *(const u32x4*)(xp - 3 * INC); rows[1] = *(const u32x4*)(xp - 2 * INC); rows[2] = *(const u32x4*)(xp - INC); }
              float w0[8], w1[8], w2[8], w3[8], cbv[8];
#pragma unroll
              for (int j = 0; j < 8; ++j) { w0[j] = a.in[I_LCW][jc + j]; w1[j] = a.in[I_LCW][1024 + jc + j]; w2[j] = a.in[I_LCW][2048 + jc + j]; w3[j] = a.in[I_LCW][3072 + jc + j]; cbv[j] = a.in[I_LCB][jc + j]; }
#pragma unroll
              for (int tt = 0; tt < 16; ++tt) { u32x4 w;
#pragma unroll
                  for (int k = 0; k < 4; ++k) {
                      const float lo = cbv[2 * k] + w0[2 * k] * bf_lo(rows[tt][k]) + w1[2 * k] * bf_lo(rows[tt + 1][k]) + w2[2 * k] * bf_lo(rows[tt + 2][k]) + w3[2 * k] * bf_lo(rows[tt + 3][k]);
                      const float hi = cbv[2 * k + 1] + w0[2 * k + 1] * bf_hi(rows[tt][k]) + w1[2 * k + 1] * bf_hi(rows[tt + 1][k]) + w2[2 * k + 1] * bf_hi(rows[tt + 2][k]) + w3[2 * k + 1] * bf_hi(rows[tt + 3][k]);
                      w[k] = cvt_pk_bf16(lo, hi); }
                  *(LAS u32x4*)(WL + (16 * tg + tt) * 136 + c0) = w; } }
            WAVE_SYNC();
            bf16x8 Af[4][4];
#pragma unroll
            for (int m = 0; m < 4; ++m)
#pragma unroll
                for (int ks = 0; ks < 4; ++ks) Af[m][ks] = *(const LAS bf16x8*)(WL + (16 * m + fr) * 136 + 32 * ks + 8 * fq);
            unsigned* SCrow = SC + (row0 + t0) * 1024 + 128 * h;
            const bf16* wa_l = WAT + ((size_t)h * 128 + fr) * 128 + 8 * fq; const bf16* wx_l = WXT + ((size_t)h * 128 + fr) * 128 + 8 * fq;
            const float* pba = a.in[I_LBA] + 128 * h + fr; const float* pbx = a.in[I_LBX] + 128 * h + fr; const float* plm = a.in[I_LAM] + 128 * h + fr;
            bf16x8 Ba[4], Bx[4]; float q0[3];
#pragma unroll
            for (int ks = 0; ks < 4; ++ks) { Ba[ks] = *(const bf16x8*)(wa_l + 32 * ks); Bx[ks] = *(const bf16x8*)(wx_l + 32 * ks); }
            q0[0] = pba[0]; q0[1] = pbx[0]; q0[2] = plm[0];
#pragma unroll 1
            for (int nt = 0; nt < 8; ++nt) {
                f32x4 ar[4], ax[4];
#pragma unroll
                for (int m = 0; m < 4; ++m) { ar[m] = (f32x4){0.f, 0.f, 0.f, 0.f}; ax[m] = ar[m]; }
#pragma unroll
                for (int ks = 0; ks < 4; ++ks)
#pragma unroll
                    for (int m = 0; m < 4; ++m) { ar[m] = __builtin_amdgcn_mfma_f32_16x16x32_bf16(Af[m][ks], Ba[ks], ar[m], 0, 0, 0); ax[m] = __builtin_amdgcn_mfma_f32_16x16x32_bf16(Af[m][ks], Bx[ks], ax[m], 0, 0, 0); }
                const float c_ba = q0[0], c_bx = q0[1], c_lm = q0[2];
                const int nn = (nt + 1) & 7;
#pragma unroll
                for (int ks = 0; ks < 4; ++ks) { Ba[ks] = *(const bf16x8*)(wa_l + nn * 2048 + 32 * ks); Bx[ks] = *(const bf16x8*)(wx_l + nn * 2048 + 32 * ks); }
                q0[0] = pba[16 * nn]; q0[1] = pbx[16 * nn]; q0[2] = plm[16 * nn];
                lru_nt_scan(ar, ax, c_ba, c_bx, c_lm, WL, carryL, SCrow, nt, fr, fq);
            }
            WAVE_SYNC();
        }
        *(f32x2*)(CARRY + ((size_t)tile * 1024 + 128 * h + lane) * 2) = carryL[lane]; *(f32x2*)(CARRY + ((size_t)tile * 1024 + 128 * h + 64 + lane) * 2) = carryL[64 + lane];
        __syncthreads();
    }
}

__device__ __forceinline__ void phase_mixer2(const Args& a, LAS unsigned char* lds, int wave, int lane) {
    unsigned char* ws = a.ws;
    const bf16* P = (const bf16*)(ws + WS_P); bf16* Y = (bf16*)(ws + WS_Y); const unsigned* SC = (const unsigned*)(ws + WS_SC);
    const float* SSG = (const float*)(ws + WS_SSG); const float* CARRY = (const float*)(ws + WS_CARRY); float* RSG = (float*)(ws + WS_RSG);
    LAS float* carry = (LAS float*)lds;
    for (int tile = blockIdx.x; tile < NTILE; tile += gridDim.x) {
        const int b = tile >> 6, ch = tile & (NCHUNK - 1); const size_t row0 = (size_t)tile * 128;
        { const int j = wave * 64 + lane; const float* cp = CARRY + ((size_t)(b * NCHUNK) * 1024 + j) * 2;
          float ca = 0.f, cb = 0.f; int cc = 0;
          for (; cc + 8 <= ch; cc += 8) { f32x2 ea[8], eb[8];
#pragma unroll
              for (int u = 0; u < 8; ++u) { ea[u] = *(const f32x2*)(cp + (size_t)(cc + u) * 2048); eb[u] = *(const f32x2*)(cp + (size_t)(cc + u) * 2048 + 1024); }
#pragma unroll
              for (int u = 0; u < 8; ++u) { ca = ea[u].x * ca + ea[u].y; cb = eb[u].x * cb + eb[u].y; } }
          for (; cc < ch; ++cc) { const f32x2 ea = *(const f32x2*)(cp + (size_t)cc * 2048), eb = *(const f32x2*)(cp + (size_t)cc * 2048 + 1024); ca = ea.x * ca + ea.y; cb = eb.x * cb + eb.y; }
          carry[j] = ca; carry[j + 512] = cb; }
        __syncthreads();
        float cr[16];
#pragma unroll
        for (int k = 0; k < 8; ++k) { cr[k] = carry[8 * lane + k]; cr[8 + k] = carry[512 + 8 * lane + k]; }
#pragma unroll 1
        for (int i = 0; i < 16; i += 2) {
            u32x4 s0[2], s1[2], s2[2], s3[2], g0[2], g1[2]; f32x4 qq[2][4];
#pragma unroll
            for (int r = 0; r < 2; ++r) { const size_t row = row0 + 16 * wave + i + r;
                const unsigned* scp = SC + row * 1024 + 8 * lane; s0[r] = *(const u32x4*)scp; s1[r] = *(const u32x4*)(scp + 4); s2[r] = *(const u32x4*)(scp + 512); s3[r] = *(const u32x4*)(scp + 516);
                const bf16* gp = P + row * INC + 2048 + 8 * lane; g0[r] = *(const u32x4*)gp; g1[r] = *(const u32x4*)(gp + 512);
#pragma unroll
                for (int k = 0; k < 4; ++k) qq[r][k] = *(const f32x4*)(SSG + row * 16 + 4 * k); }
#pragma unroll
            for (int r = 0; r < 2; ++r) { const size_t row = row0 + 16 * wave + i + r;
                float y[16]; float q = 0.f;
#pragma unroll
                for (int k = 0; k < 8; ++k) { const unsigned sa = k < 4 ? s0[r][k & 3] : s1[r][k & 3], sb = k < 4 ? s2[r][k & 3] : s3[r][k & 3];
                    const unsigned ga = g0[r][k >> 1], gb = g1[r][k >> 1]; const float gva = (k & 1) ? bf_hi(ga) : bf_lo(ga), gvb = (k & 1) ? bf_hi(gb) : bf_lo(gb);
                    y[k] = (bf_lo(sa) + bf_hi(sa) * cr[k]) * gva; y[8 + k] = (bf_lo(sb) + bf_hi(sb) * cr[8 + k]) * gvb; q += y[k] * y[k] + y[8 + k] * y[8 + k]; }
                const float sl = __builtin_amdgcn_rsqf(wave_sum(q) * (1.0f / 1024.0f) + RMS_EPS);
                u32x4 o0, o1;
#pragma unroll
                for (int k = 0; k < 4; ++k) { o0[k] = cvt_pk_bf16(y[2 * k] * sl, y[2 * k + 1] * sl); o1[k] = cvt_pk_bf16(y[8 + 2 * k] * sl, y[8 + 2 * k + 1] * sl); }
                bf16* yp = Y + row * DM + 8 * lane;
                *(u32x4*)(yp + 1024) = o0; *(u32x4*)(yp + 1024 + 512) = o1;
                const f32x4 qs = (qq[r][0] + qq[r][1]) + (qq[r][2] + qq[r][3]);
                const float sg = __builtin_amdgcn_rsqf(((qs[0] + qs[1]) + (qs[2] + qs[3])) * (1.0f / 1024.0f) + RMS_EPS);
                if (lane == 0) RSG[row] = sg; }
        }
        __syncthreads();
    }
}

__device__ __forceinline__ void phase_fixup(const Args& a, int wave, int lane) {
    unsigned char* ws = a.ws; const float* halo = (const float*)(ws + WS_HALO); bf16* ACT = (bf16*)(ws + WS_ACT);
    const float* cw = a.in[I_FCW]; const float* cb = a.in[I_FCB];
    const int gt = blockIdx.x * NTHREADS + wave * 64 + lane, NGT = gridDim.x * NTHREADS;
    for (int idx = gt; idx < 256 * 2 * 1536; idx += NGT) { const int c = 4 * (idx % 1536), rr = (idx / 1536) & 1, g = idx / 3072; const bool first = (g & 63) == 0;
        const size_t row = (size_t)g * 128 + rr;
        f32x4 o[2];
#pragma unroll
        for (int bj = 0; bj < 2; ++bj) { const f32x4 z = (f32x4){0.f, 0.f, 0.f, 0.f};
            const f32x4 cur = *(const f32x4*)(halo + ((size_t)(g * 4 + rr) * 2 + bj) * 6144 + c);
            f32x4 p1, p2;
            if (rr == 0) { p1 = first ? z : *(const f32x4*)(halo + ((size_t)((g - 1) * 4 + 3) * 2 + bj) * 6144 + c); p2 = first ? z : *(const f32x4*)(halo + ((size_t)((g - 1) * 4 + 2) * 2 + bj) * 6144 + c); }
            else { p1 = *(const f32x4*)(halo + ((size_t)(g * 4 + 0) * 2 + bj) * 6144 + c); p2 = first ? z : *(const f32x4*)(halo + ((size_t)((g - 1) * 4 + 3) * 2 + bj) * 6144 + c); }
            const int pc = bj * DFF + c;
            o[bj] = *(const f32x4*)(cb + pc) + *(const f32x4*)(cw + 2 * NUP + pc) * cur + *(const f32x4*)(cw + NUP + pc) * p1 + *(const f32x4*)(cw + pc) * p2; }
        u32x2 w; w.x = cvt_pk_bf16(gelu_tanh(o[0][0]) * o[1][0], gelu_tanh(o[0][1]) * o[1][1]); w.y = cvt_pk_bf16(gelu_tanh(o[0][2]) * o[1][2], gelu_tanh(o[0][3]) * o[1][3]);
        *(u32x2*)(ACT + row * DFF + c) = w; }
}

__device__ __forceinline__ void phase_final(const Args& a, int wave, int lane) {
    const float* ss3 = (const float*)(a.ws + WS_SS3); const bf16* X2 = (const bf16*)(a.ws + WS_X1B);
    const int gw = blockIdx.x * NWAVES + wave, NGW = gridDim.x * NWAVES;
    f32x4 g[8];
#pragma unroll
    for (int j = 0; j < 4; ++j) { g[2 * j] = *(const f32x4*)(a.in[I_FG] + 512 * j + 8 * lane); g[2 * j + 1] = *(const f32x4*)(a.in[I_FG] + 512 * j + 8 * lane + 4); }
    for (int m = gw; m < M; m += 4 * NGW) {
        u32x4 v[4][4]; float rs[4];
#pragma unroll
        for (int r = 0; r < 4; ++r) { const bf16* xr = X2 + (size_t)(m + r * NGW) * DM + 8 * lane; rs[r] = ss3[m + r * NGW];
#pragma unroll
            for (int j = 0; j < 4; ++j) v[r][j] = *(const u32x4*)(xr + 512 * j); }
#pragma unroll
        for (int r = 0; r < 4; ++r) { const float s = __builtin_amdgcn_rsqf(rs[r] * (1.0f / DM) + RMS_EPS); float* orow = a.out + (size_t)(m + r * NGW) * DM + 8 * lane;
#pragma unroll
            for (int j = 0; j < 4; ++j) { const f32x4 lo = (f32x4){bf_lo(v[r][j][0]), bf_hi(v[r][j][0]), bf_lo(v[r][j][1]), bf_hi(v[r][j][1])}, hi = (f32x4){bf_lo(v[r][j][2]), bf_hi(v[r][j][2]), bf_lo(v[r][j][3]), bf_hi(v[r][j][3])};
                *(f32x4*)(orow + 512 * j) = lo * s * g[2 * j]; *(f32x4*)(orow + 512 * j + 4) = hi * s * g[2 * j + 1]; } } }
}

#ifndef MK_N_LAUNCHES
#define MK_N_LAUNCHES 1
#endif
constexpr int N_PHASES = 9;
__global__ void __launch_bounds__(NTHREADS, 2) hymba_fwd(Args a) {
    extern __shared__ __attribute__((aligned(16))) unsigned char lds_raw[];
    LAS unsigned char* lds = (LAS unsigned char*)lds_raw;
    cg::grid_group grid = cg::this_grid();
    const int wave = __builtin_amdgcn_readfirstlane(threadIdx.x >> 6);
#define LANE() ((int)__builtin_amdgcn_mbcnt_hi(~0u, __builtin_amdgcn_mbcnt_lo(~0u, 0u)))
    unsigned char* ws = a.ws;
    const int lo = a.ph_lo, hi = a.ph_hi;
#ifndef PH_MASK
#define PH_MASK 0x1ff
#endif
#define IN(k) (((PH_MASK >> (k)) & 1) && lo <= (k) && (k) < hi)
#ifndef REP_MASK
#define REP_MASK 0
#endif
#define REPS(k) for (int rep_ = 0; rep_ < 1 + ((REP_MASK >> (k)) & 1); ++rep_)
#define SEAM(k) do { if (IN(k) && IN((k) + 1)) grid.sync(); } while (0)
    if (IN(0)) REPS(0) { phase_prologue(a, lds, wave, LANE()); } SEAM(0);
    if (IN(1)) REPS(1) { pg8::Gemm g{(const bf16*)(ws + WS_X1B), (const bf16*)(ws + WS_WIN), M, INC, DM}; pg8::StaticOrder S; S.init(M, INC, gridDim.x, blockIdx.x);
        pg8::EpiP E{(bf16*)(ws + WS_P), (const float*)(ws + WS_RS1), lds + pg8::STAGE_BYTES}; pg8::gemm_phase<pg8::EpiP, pg8::StaticOrder, true, true, false>(lds, g, S, E, wave); } SEAM(1);
    if (IN(2)) REPS(2) { phase_mixer(a, lds, wave, LANE()); } SEAM(2);
    if (IN(3)) { phase_mixer2(a, lds, wave, LANE()); } SEAM(3);
    if (IN(4)) { pg8::Gemm g{(const bf16*)(ws + WS_Y), (const bf16*)(ws + WS_WOUT), M, DM, DM}; pg8::StaticOrder S; S.init(M, DM, gridDim.x, blockIdx.x);
        pg8::EpiRes<true, true> E{nullptr, (bf16*)(ws + WS_X1B), (float*)(ws + WS_SS2), (const float*)(ws + WS_RSG)}; pg8::gemm_phase<pg8::EpiRes<true, true>, pg8::StaticOrder, true, true, false>(lds, g, S, E, wave); } SEAM(4);
    if (IN(5)) REPS(5) { pg8::Gemm g{(const bf16*)(ws + WS_X1B), (const bf16*)(ws + WS_WUP), M, NUP, DM}; pg8::StaticOrder S; S.init(M, NUP, gridDim.x, blockIdx.x);
        pg8::EpiUp E{(const float*)(ws + WS_SS2), a.in[I_FCW], a.in[I_FCB], (bf16*)(ws + WS_ACT), (float*)(ws + WS_HALO), lds + pg8::STAGE_BYTES}; pg8::gemm_phase<pg8::EpiUp, pg8::StaticOrder, true, true, true>(lds, g, S, E, wave); } SEAM(5);
    if (IN(6)) { phase_fixup(a, wave, LANE()); } SEAM(6);
    if (IN(7)) { pg8::Gemm g{(const bf16*)(ws + WS_ACT), (const bf16*)(ws + WS_WDN), M, DM, DFF}; pg8::StaticOrder S; S.init(M, DM, gridDim.x, blockIdx.x);
        pg8::EpiRes<true, false> E{nullptr, (bf16*)(ws + WS_X1B), (float*)(ws + WS_SS3), nullptr}; pg8::gemm_phase<pg8::EpiRes<true, false>, pg8::StaticOrder, true, true, false>(lds, g, S, E, wave); } SEAM(7);
    if (IN(8)) { phase_final(a, wave, LANE()); }
#undef IN
#undef SEAM
}

extern "C" void kernel_launch(void* const* d_in, const int* in_sizes, int n_in, void* d_out, int out_size, void* d_ws, size_t ws_size, hipStream_t stream) {
    static int grid = 0;
    if (grid == 0) {
        if (n_in != 23 || out_size != M * DM || ws_size < WS_END) { fprintf(stderr, "kernel_launch: unexpected problem (n_in %d, out %d, ws %zu)\n", n_in, out_size, ws_size); grid = -1; return; }
        int dev = 0, cus = 0, per_cu = 0;
        hipGetDevice(&dev); hipDeviceGetAttribute(&cus, hipDeviceAttributeMultiprocessorCount, dev);
        if (hipFuncSetAttribute((const void*)hymba_fwd, hipFuncAttributeMaxDynamicSharedMemorySize, LDS_BYTES) != hipSuccess) { fprintf(stderr, "kernel_launch: hipFuncSetAttribute failed\n"); grid = -1; return; }
        if (hipOccupancyMaxActiveBlocksPerMultiprocessor(&per_cu, (const void*)hymba_fwd, NTHREADS, LDS_BYTES) != hipSuccess || per_cu < 1) { fprintf(stderr, "kernel_launch: occupancy query says %d\n", per_cu); per_cu = 1; }
        (void)hipGetLastError();
        grid = cus;
    }
    if (grid < 0) return;
    Args a{};
    for (int i = 0; i < 23; ++i) a.in[i] = (const float*)d_in[i];
    a.out = (float*)d_out; a.ws = (unsigned char*)d_ws;
#if MK_N_LAUNCHES == 1
    a.ph_lo = 0; a.ph_hi = N_PHASES;
    void* args[] = {&a};
    hipError_t e = hipLaunchCooperativeKernel((const void*)hymba_fwd, dim3(grid), dim3(NTHREADS), args, LDS_BYTES, stream);
    if (e != hipSuccess) fprintf(stderr, "kernel_launch: cooperative launch failed: %s (grid %d)\n", hipGetErrorString(e), grid);
#else
#ifndef DUP_PHASE
#define DUP_PHASE -1
#endif
    for (int p = 0; p < N_PHASES; ++p) { a.ph_lo = p; a.ph_hi = p + 1; hipLaunchKernelGGL(hymba_fwd, dim3(grid), dim3(NTHREADS), LDS_BYTES, stream, a);
        if (p == DUP_PHASE) hipLaunchKernelGGL(hymba_fwd, dim3(grid), dim3(NTHREADS), LDS_BYTES, stream, a); }
#endif
}
```
